# Optimizing an MI355X kernel written in HIP

```python
import jax, jax.numpy as jnp
from jax import lax
import numpy as np

D_MODEL = 2048
BATCH = 16
SEQ = 256
DEPTH = 2
DEC_BATCH = 2
DEC_SEQ = 1024
PAST_LEN = 512

GRID_W = 64
CHUNK_MLP = 128
A_WIDTH = D_MODEL // 4
A_GROUPS = 4
A_GDIM = A_WIDTH // A_GROUPS
B_HDIM = 64
B_WIDTH = 3 * D_MODEL // 8
B_HEADS = B_WIDTH // B_HDIM
DECAY_LORA = 64
AAA_LORA = 64
GATE_LORA = 128
C_KDIM = 128
C_WIDTH = D_MODEL - A_WIDTH - B_WIDTH
C_HEADS = C_WIDTH // C_KDIM
C_VDIM = C_WIDTH // C_HEADS
C_CHUNK = 16
D_FF = 5632
A_COLS = 2 * A_WIDTH
B_COLS = 3 * B_WIDTH + 2 * DECAY_LORA + 2 * AAA_LORA + GATE_LORA
C_COLS = 5 * C_WIDTH
IN_COLS = A_COLS + B_COLS + C_COLS
MIX_WIDTH = A_WIDTH + B_WIDTH + C_WIDTH
B_SPLITS = (B_WIDTH, 2 * B_WIDTH, 3 * B_WIDTH, 3 * B_WIDTH + 2 * DECAY_LORA,
            3 * B_WIDTH + 2 * DECAY_LORA + 2 * AAA_LORA)
N_MOD = 9
EPS = 1e-6
LNX_EPS = 64e-5

kernel_name = 'hybrid_gmlp_rwkv7_hgrn2_diffusion_step'


def rmsnorm(x, g):
    xf = x.astype(jnp.float32)
    y = xf * lax.rsqrt(jnp.mean(xf * xf, axis=-1, keepdims=True) + EPS)
    return (y * g.astype(jnp.float32)).astype(x.dtype)


def swiglu(h, w1, w3, w2):
    return (jax.nn.silu(h @ w1) * (h @ w3)) @ w2


def centred_shift(x):
    prev = jnp.pad(x[:, :-1], ((0, 0), (1, 0), (0, 0)))
    nxt = jnp.pad(x[:, 1:], ((0, 0), (0, 1), (0, 0)))
    return 0.5 * (prev + nxt)


def chunk_mlp_mix(za, n_chunks, ng, ws, bs):
    bsz, t = za.shape[0], za.shape[1]
    u, v = jnp.split(jax.nn.gelu(za), 2, axis=-1)
    v = rmsnorm(v.reshape(bsz, n_chunks, CHUNK_MLP, A_GROUPS, A_GDIM), ng)
    v = jnp.einsum('gpq,bnqgc->bnpgc', ws, v) + bs.T[:, :, None]
    return u * v.reshape(bsz, t, A_WIDTH)


def rwkv_scan(r, w, k, v, a, b, s0):
    def step(S, inp):
        r_t, w_t, k_t, v_t, a_t, b_t = inp
        sa = jnp.einsum('bhvk,bhk->bhv', S, a_t)
        S = S * w_t[:, :, None, :] + sa[..., None] * b_t[:, :, None, :] + v_t[..., None] * k_t[:, :, None, :]
        return S, jnp.einsum('bhvk,bhk->bhv', S, r_t)
    xs = tuple(jnp.moveaxis(z, 1, 0) for z in (r, w, k, v, a, b))
    s_fin, y = lax.scan(step, s0.astype(jnp.float32), xs)
    return jnp.moveaxis(y, 0, 1), s_fin


def rwkv7_mix(zb, s0, mu, w0, w2, a0, a2, g2, kk_w, ka_w, r_k, lnx_g, lnx_b):
    zb = zb + (centred_shift(zb) - zb) * mu
    bsz, t = zb.shape[0], zb.shape[1]
    r, k, v, wd, ad, gd = jnp.split(zb, B_SPLITS, axis=-1)
    wd = wd.reshape(bsz, t, 2, DECAY_LORA)
    ad = ad.reshape(bsz, t, 2, AAA_LORA)
    w_raw = w0 + jnp.einsum('btdr,drc->btdc', jnp.tanh(wd), w2)
    decay = jnp.exp(-jnp.exp(-jax.nn.softplus(-w_raw) - 0.5))
    a = jax.nn.sigmoid(a0 + jnp.einsum('btdr,drc->btdc', ad, a2))
    gate = jax.nn.sigmoid(gd) @ g2
    kd = k[:, :, None] * (1.0 + (a - 1.0) * ka_w)
    hd = lambda z: z.reshape(z.shape[:-1] + (B_HEADS, B_HDIM))
    kk = hd(k * kk_w)
    kk = kk / jnp.maximum(jnp.sqrt(jnp.sum(kk * kk, axis=-1, keepdims=True)), 1e-12)
    r_h, v_h = hd(r), hd(v)
    ys, states, bonus = [], [], []
    for d in range(2):
        k_d = hd(kd[:, :, d])
        seq = (r_h, hd(decay[:, :, d]), k_d, v_h, -kk, kk * hd(a[:, :, d]))
        if d == 1:
            seq = tuple(jnp.flip(s_, axis=1) for s_ in seq)
        y, s_fin = rwkv_scan(*seq, s0[:, d])
        ys.append(jnp.flip(y, axis=1) if d == 1 else y)
        states.append(s_fin)
        bonus.append(jnp.sum(r_h * k_d * r_k, axis=-1, keepdims=True) * v_h)
    y = ys[0] + ys[1]
    mean = jnp.mean(y, axis=-1, keepdims=True)
    var = jnp.mean(jnp.square(y - mean), axis=-1, keepdims=True)
    y = (y - mean) * lax.rsqrt(var + LNX_EPS) * lnx_g + lnx_b + bonus[0] + bonus[1]
    return y.reshape(bsz, t, B_WIDTH) * gate, jnp.stack(states, axis=1)


def gla_chunked(q, k, v, logf, s0):
    bsz, t, nh, dk = q.shape
    dv = v.shape[-1]
    nc = t // C_CHUNK
    q, k, logf = (z.reshape(bsz, nc, C_CHUNK, nh, dk) for z in (q, k, logf))
    v = v.reshape(bsz, nc, C_CHUNK, nh, dv)
    b = jnp.cumsum(logf, axis=2)
    mask = jnp.tril(jnp.ones((C_CHUNK, C_CHUNK), dtype=bool))[None, None, :, :, None, None]
    dec = jnp.exp(jnp.where(mask, b[:, :, :, None] - b[:, :, None, :], -jnp.inf))
    att = jnp.einsum('bnihk,bnjhk,bnijhk->bnhij', q, k, dec)
    o_intra = jnp.einsum('bnhij,bnjhv->bnihv', att, v)
    b_end = b[:, :, -1]
    kv = jnp.einsum('bnjhk,bnjhv->bnhkv', k * jnp.exp(b_end[:, :, None] - b), v)

    def step(S, inp):
        cdec, kv_c = inp
        return cdec[..., None] * S + kv_c, S
    s_fin, s_start = lax.scan(step, s0.astype(jnp.float32),
                              (jnp.moveaxis(jnp.exp(b_end), 1, 0), jnp.moveaxis(kv, 1, 0)))
    s_start = jnp.moveaxis(s_start, 0, 1)
    o_inter = jnp.einsum('bnihk,bnhkv->bnihv', q * jnp.exp(b), s_start)
    return (o_intra + o_inter).reshape(bsz, t, nh, dv), s_fin


def hgrn2_mix(zc, s0, lb, gn_g):
    bsz, t = zc.shape[0], zc.shape[1]
    q, f2, iv, g = jnp.split(zc, (C_WIDTH, 3 * C_WIDTH, 4 * C_WIDTH), axis=-1)
    hk = lambda z: z.reshape(bsz, t, C_HEADS, C_KDIM)
    hv = lambda z: z.reshape(bsz, t, C_HEADS, C_VDIM)
    q = hk(jax.nn.silu(q))
    v = hv(iv)
    fg = lb + (1.0 - lb) * jax.nn.sigmoid(f2.reshape(bsz, t, 2, C_WIDTH))
    logf = jnp.log(fg)
    kg = 1.0 - fg
    outs, states = [], []
    for d in range(2):
        seq = (q, hk(kg[:, :, d]), v, hk(logf[:, :, d]))
        if d == 1:
            seq = tuple(jnp.flip(s_, axis=1) for s_ in seq)
        o, s_fin = gla_chunked(*seq, s0[:, d])
        outs.append(jnp.flip(o, axis=1) if d == 1 else o)
        states.append(s_fin)
    o = rmsnorm(outs[0] + outs[1], gn_g) * jax.nn.silu(hv(g))
    return o.reshape(bsz, t, C_WIDTH), jnp.stack(states, axis=1)


def trunk_layer(x, cond, s_rw0, s_hg0, n_chunks, l, P):
    mod = jax.nn.silu(cond) @ P['w_mod'][l] + P['b_mod'][l]
    mod = mod.reshape(cond.shape[0], 1, N_MOD, D_MODEL).astype(x.dtype)
    sh1, sc1, gt1, sh2, sc2, gt2, sh3, sc3, gt3 = [mod[:, :, i] for i in range(N_MOD)]
    h = rmsnorm(x, P['norm_g'][l, 0]) * (1 + sc1) + sh1
    x = x + 0.5 * gt1 * swiglu(h, P['ffn_w1'][l, 0], P['ffn_w3'][l, 0], P['ffn_w2'][l, 0])
    h = rmsnorm(x, P['norm_g'][l, 1]) * (1 + sc2) + sh2
    z = (h @ P['w_in'][l]).astype(jnp.float32)
    za, zb, zc = jnp.split(z, (A_COLS, A_COLS + B_COLS), axis=-1)
    oa = chunk_mlp_mix(za, n_chunks, P['mlp_norm_g'][l], P['mlp_ws'][l], P['mlp_bs'][l])
    ob, s_rw = rwkv7_mix(zb, s_rw0, P['rwkv_mu'][l], P['rwkv_w0'][l], P['rwkv_w2'][l],
                         P['rwkv_a0'][l], P['rwkv_a2'][l], P['rwkv_g2'][l], P['rwkv_kk'][l],
                         P['rwkv_ka'][l], P['rwkv_rk'][l], P['rwkv_lnx_g'][l], P['rwkv_lnx_b'][l])
    oc, s_hg = hgrn2_mix(zc, s_hg0, P['hgrn_lb'][l], P['hgrn_gn'][l])
    o = jnp.concatenate([oa, ob, oc], axis=-1).astype(x.dtype)
    x = x + gt2 * (o @ P['w_out'][l])
    h = rmsnorm(x, P['norm_g'][l, 2]) * (1 + sc3) + sh3
    x = x + 0.5 * gt3 * swiglu(h, P['ffn_w1'][l, 1], P['ffn_w3'][l, 1], P['ffn_w2'][l, 1])
    return x, s_rw, s_hg


def setup_inputs(seed: int = 0) -> dict:
    key = jax.random.key(seed)
    ks = iter(jax.random.split(key, 40))
    f32 = jnp.float32
    nrm = lambda shape, s: jax.random.normal(next(ks), shape, f32) * s
    uni = lambda shape, lo, hi: jax.random.uniform(next(ks), shape, f32, lo, hi)
    return {
        'x_prompt': nrm((BATCH, SEQ, D_MODEL), 1.0),
        'x_sample': nrm((DEC_BATCH, DEC_SEQ, D_MODEL), 1.0),
        'state_rwkv': nrm((DEC_BATCH, DEPTH, 2, B_HEADS, B_HDIM, B_HDIM), 0.5),
        'state_hgrn': nrm((DEC_BATCH, DEPTH, 2, C_HEADS, C_KDIM, C_VDIM), 0.5),
        'c': nrm((DEC_BATCH, D_MODEL), 1.0),
        'c_ctx': nrm((D_MODEL,), 1.0),
        'norm_g': 1.0 + nrm((DEPTH, 3, D_MODEL), 0.05),
        'w_mod': nrm((DEPTH, D_MODEL, N_MOD * D_MODEL), 0.5 * D_MODEL ** -0.5),
        'b_mod': nrm((DEPTH, N_MOD * D_MODEL), 0.02),
        'ffn_w1': nrm((DEPTH, 2, D_MODEL, D_FF), D_MODEL ** -0.5),
        'ffn_w3': nrm((DEPTH, 2, D_MODEL, D_FF), D_MODEL ** -0.5),
        'ffn_w2': nrm((DEPTH, 2, D_FF, D_MODEL), D_FF ** -0.5),
        'w_in': nrm((DEPTH, D_MODEL, IN_COLS), D_MODEL ** -0.5),
        'w_out': nrm((DEPTH, MIX_WIDTH, D_MODEL), MIX_WIDTH ** -0.5),
        'mlp_norm_g': 1.0 + nrm((DEPTH, A_GROUPS, A_GDIM), 0.05),
        'mlp_ws': nrm((DEPTH, A_GROUPS, CHUNK_MLP, CHUNK_MLP), CHUNK_MLP ** -0.5),
        'mlp_bs': 1.0 + nrm((DEPTH, A_GROUPS, CHUNK_MLP), 0.1),
        'rwkv_mu': uni((DEPTH, B_COLS), 0.0, 1.0),
        'rwkv_w0': uni((DEPTH, 2, B_WIDTH), -6.0, -1.0),
        'rwkv_w2': nrm((DEPTH, 2, DECAY_LORA, B_WIDTH), 0.1 * DECAY_LORA ** -0.5),
        'rwkv_a0': nrm((DEPTH, 2, B_WIDTH), 0.1),
        'rwkv_a2': nrm((DEPTH, 2, AAA_LORA, B_WIDTH), 0.5 * AAA_LORA ** -0.5),
        'rwkv_g2': nrm((DEPTH, GATE_LORA, B_WIDTH), GATE_LORA ** -0.5),
        'rwkv_kk': 0.85 + nrm((DEPTH, B_WIDTH), 0.05),
        'rwkv_ka': 1.0 + nrm((DEPTH, B_WIDTH), 0.05),
        'rwkv_rk': nrm((DEPTH, B_HEADS, B_HDIM), 0.1),
        'rwkv_lnx_g': 1.0 + nrm((DEPTH, B_HEADS, B_HDIM), 0.05),
        'rwkv_lnx_b': nrm((DEPTH, B_HEADS, B_HDIM), 0.02),
        'hgrn_lb': nrm((DEPTH, 2, C_WIDTH), 1.0),
        'hgrn_gn': 1.0 + nrm((DEPTH, C_VDIM), 0.05),
        'final_g': 1.0 + nrm((D_MODEL,), 0.05),
    }


def reference(x_prompt, x_sample, state_rwkv, state_hgrn, c, c_ctx, norm_g, w_mod, b_mod,
              ffn_w1, ffn_w3, ffn_w2, w_in, w_out, mlp_norm_g, mlp_ws, mlp_bs, rwkv_mu,
              rwkv_w0, rwkv_w2, rwkv_a0, rwkv_a2, rwkv_g2, rwkv_kk, rwkv_ka, rwkv_rk,
              rwkv_lnx_g, rwkv_lnx_b, hgrn_lb, hgrn_gn, final_g):
    sm = jax.nn.softmax(hgrn_lb.astype(jnp.float32), axis=0)
    lower_bounds = jnp.cumsum(sm, axis=0) - sm[0]
    P = {'w_mod': w_mod, 'b_mod': b_mod, 'norm_g': norm_g, 'ffn_w1': ffn_w1, 'ffn_w3': ffn_w3,
         'ffn_w2': ffn_w2, 'w_in': w_in, 'w_out': w_out, 'mlp_norm_g': mlp_norm_g,
         'mlp_ws': mlp_ws, 'mlp_bs': mlp_bs, 'rwkv_mu': rwkv_mu, 'rwkv_w0': rwkv_w0,
         'rwkv_w2': rwkv_w2, 'rwkv_a0': rwkv_a0, 'rwkv_a2': rwkv_a2, 'rwkv_g2': rwkv_g2,
         'rwkv_kk': rwkv_kk, 'rwkv_ka': rwkv_ka, 'rwkv_rk': rwkv_rk, 'rwkv_lnx_g': rwkv_lnx_g,
         'rwkv_lnx_b': rwkv_lnx_b, 'hgrn_lb': lower_bounds, 'hgrn_gn': hgrn_gn}

    bsz, ctx_len = x_prompt.shape[0], x_prompt.shape[1]
    x = x_prompt
    rw_states, hg_states = [], []
    for l in range(DEPTH):
        s_rw0 = jnp.zeros((bsz, 2, B_HEADS, B_HDIM, B_HDIM), jnp.float32)
        s_hg0 = jnp.zeros((bsz, 2, C_HEADS, C_KDIM, C_VDIM), jnp.float32)
        x, s_rw, s_hg = trunk_layer(x, c_ctx[None], s_rw0, s_hg0, ctx_len // CHUNK_MLP, l, P)
        rw_states.append(s_rw)
        hg_states.append(s_hg)
    y_prompt = rmsnorm(x, final_g)
    new_state_rwkv = jnp.stack(rw_states, axis=1)
    new_state_hgrn = jnp.stack(hg_states, axis=1)

    rows = x_sample.shape[1] // GRID_W
    n_chunks = rows * GRID_W // CHUNK_MLP
    x = x_sample
    for l in range(DEPTH):
        x, _, _ = trunk_layer(x, c, state_rwkv[:, l], state_hgrn[:, l], n_chunks, l, P)
    y_sample = rmsnorm(x, final_g)
    return (y_prompt, y_sample, new_state_rwkv, new_state_hgrn)
```

```cpp
#include <hip/hip_runtime.h>
#include <stdint.h>

#define D 2048
#define NTOK 6144
#define DFF 5632
#define INC 7552
#define BW 768
#define NMODC 18432

__device__ __forceinline__ int cond_of_row(int m) { return m < 4096 ? 0 : 1 + ((m - 4096) >> 10); }
__device__ __forceinline__ float sigmoidf_(float x) { return 1.f / (1.f + __expf(-x)); }
__device__ __forceinline__ float siluf_(float x) { return x / (1.f + __expf(-x)); }
__device__ __forceinline__ float gelu_tanh(float x) { const float u = 0.7978845608028654f * (x + 0.044715f * x * x * x); return 0.5f * x * (1.f + tanhf(u)); }
__device__ __forceinline__ float wave_sum(float v) {
#pragma unroll
    for (int o = 1; o < 64; o <<= 1) v += __shfl_xor(v, o);
    return v;
}

__global__ __launch_bounds__(256) void k_mod_partial(const float* c, const float* c_ctx, const float* w_mod, float* part) {
    const int j = blockIdx.x * 256 + threadIdx.x, l = blockIdx.y, ks = blockIdx.z;
    const float* w = w_mod + (size_t)l * D * NMODC;
    float a0 = 0.f, a1 = 0.f, a2 = 0.f;
    for (int k = ks * 128; k < ks * 128 + 128; ++k) {
        const float wv = w[(size_t)k * NMODC + j];
        a0 += siluf_(c_ctx[k]) * wv; a1 += siluf_(c[k]) * wv; a2 += siluf_(c[D + k]) * wv;
    }
    float* p = part + ((size_t)(ks * 2 + l) * 3) * NMODC;
    p[j] = a0; p[NMODC + j] = a1; p[2 * NMODC + j] = a2;
}
__global__ __launch_bounds__(256) void k_mod_reduce(const float* part, const float* b_mod, float* mod) {
    const int j = blockIdx.x * 256 + threadIdx.x, l = blockIdx.y, cd = blockIdx.z;
    float a = b_mod[(size_t)l * NMODC + j];
    for (int ks = 0; ks < 16; ++ks) a += part[((size_t)(ks * 2 + l) * 3 + cd) * NMODC + j];
    mod[((size_t)l * 3 + cd) * NMODC + j] = a;
}

__global__ __launch_bounds__(256) void k_norm_mod(const float* x, const float* g, const float* mod, int sh_idx, float* h) {
    __shared__ float red[4];
    const int m = blockIdx.x, tid = threadIdx.x;
    const float* xr = x + (size_t)m * D;
    float v[8]; float ss = 0.f;
#pragma unroll
    for (int i = 0; i < 8; ++i) { v[i] = xr[tid + 256 * i]; ss += v[i] * v[i]; }
    ss = wave_sum(ss);
    if ((tid & 63) == 0) red[tid >> 6] = ss;
    __syncthreads();
    const float tot = red[0] + red[1] + red[2] + red[3];
    const float rstd = rsqrtf(tot * (1.f / D) + 1e-6f);
    if (mod) {
        const float* sh = mod + (size_t)cond_of_row(m) * NMODC + sh_idx * D; const float* sc = sh + D;
#pragma unroll
        for (int i = 0; i < 8; ++i) { const int c = tid + 256 * i; h[(size_t)m * D + c] = v[i] * rstd * g[c] * (1.f + sc[c]) + sh[c]; }
    } else {
#pragma unroll
        for (int i = 0; i < 8; ++i) { const int c = tid + 256 * i; h[(size_t)m * D + c] = v[i] * rstd * g[c]; }
    }
}

template <int MODE>
__global__ __launch_bounds__(256) void k_gemm(const float* A, int lda, const float* B, const float* B2, int ldb, int K, float* C, int ldc, const float* gate, float scale) {
    __shared__ float As[16][64 + 4];
    __shared__ float Bs[16][64 + 4];
    __shared__ float Bs2[MODE == 1 ? 16 : 1][64 + 4];
    const int tid = threadIdx.x, tx = tid & 15, ty = tid >> 4;
    const int m0 = blockIdx.y * 64, n0 = blockIdx.x * 64;
    float acc[4][4], acc2[4][4];
#pragma unroll
    for (int i = 0; i < 4; ++i)
#pragma unroll
        for (int j = 0; j < 4; ++j) { acc[i][j] = 0.f; acc2[i][j] = 0.f; }
    const int am = tid >> 2, ak = (tid & 3) * 4;
    const int bk = tid >> 4, bn = (tid & 15) * 4;
    for (int k0 = 0; k0 < K; k0 += 16) {
        const float4 av = *(const float4*)(A + (size_t)(m0 + am) * lda + k0 + ak);
        const float4 bv = *(const float4*)(B + (size_t)(k0 + bk) * ldb + n0 + bn);
        As[ak + 0][am] = av.x; As[ak + 1][am] = av.y; As[ak + 2][am] = av.z; As[ak + 3][am] = av.w;
        *(float4*)&Bs[bk][bn] = bv;
        if (MODE == 1) { const float4 b2 = *(const float4*)(B2 + (size_t)(k0 + bk) * ldb + n0 + bn); *(float4*)&Bs2[bk][bn] = b2; }
        __syncthreads();
#pragma unroll
        for (int k = 0; k < 16; ++k) {
            const float4 a4 = *(const float4*)&As[k][ty * 4];
            const float4 b4 = *(const float4*)&Bs[k][tx * 4];
            const float a[4] = {a4.x, a4.y, a4.z, a4.w}, b[4] = {b4.x, b4.y, b4.z, b4.w};
#pragma unroll
            for (int i = 0; i < 4; ++i)
#pragma unroll
                for (int j = 0; j < 4; ++j) acc[i][j] += a[i] * b[j];
            if (MODE == 1) {
                const float4 c4 = *(const float4*)&Bs2[k][tx * 4];
                const float c[4] = {c4.x, c4.y, c4.z, c4.w};
#pragma unroll
                for (int i = 0; i < 4; ++i)
#pragma unroll
                    for (int j = 0; j < 4; ++j) acc2[i][j] += a[i] * c[j];
            }
        }
        __syncthreads();
    }
#pragma unroll
    for (int i = 0; i < 4; ++i) {
        const int m = m0 + ty * 4 + i;
#pragma unroll
        for (int j = 0; j < 4; ++j) {
            const int n = n0 + tx * 4 + j;
            float* cp = C + (size_t)m * ldc + n;
            if (MODE == 0) *cp = acc[i][j];
            else if (MODE == 1) *cp = siluf_(acc[i][j]) * acc2[i][j];
            else *cp = *cp + scale * gate[(size_t)cond_of_row(m) * NMODC + n] * acc[i][j];
        }
    }
}

__global__ __launch_bounds__(256) void k_chunk_mlp(const float* z, const float* ng, const float* ws, const float* bs, float* o) {
    __shared__ float vs[128 * 128];
    const int chunk = blockIdx.x, g = blockIdx.y, tid = threadIdx.x, wave = tid >> 6, lane = tid & 63, tok0 = chunk * 128;
    for (int q = wave; q < 128; q += 4) {
        const float* zr = z + (size_t)(tok0 + q) * INC + 512 + g * 128;
        const float a = gelu_tanh(zr[lane]), b = gelu_tanh(zr[lane + 64]);
        const float ss = wave_sum(a * a + b * b);
        const float rstd = rsqrtf(ss * (1.f / 128.f) + 1e-6f);
        vs[q * 128 + lane] = a * rstd * ng[g * 128 + lane]; vs[q * 128 + lane + 64] = b * rstd * ng[g * 128 + lane + 64];
    }
    __syncthreads();
    const int c = tid & 127, ph = tid >> 7;
    for (int p = ph * 64; p < ph * 64 + 64; ++p) {
        const float* wr = ws + ((size_t)g * 128 + p) * 128;
        float acc = 0.f;
        for (int q = 0; q < 128; ++q) acc += wr[q] * vs[q * 128 + c];
        acc += bs[g * 128 + p];
        const float u = gelu_tanh(z[(size_t)(tok0 + p) * INC + g * 128 + c]);
        o[(size_t)(tok0 + p) * D + g * 128 + c] = u * acc;
    }
}

#define ZB0 1024
__global__ __launch_bounds__(256) void k_rwkv_prep(const float* z, const float* mu, const float* w0, const float* w2, const float* a0, const float* a2, const float* g2,
                                                  const float* kkw, const float* kaw, const float* rk,
                                                  float* R, float* V, float* KK, float* GATE, float* W, float* KD, float* Bv, float* BON) {
    __shared__ float zm[4][2688];
    const int tid = threadIdx.x, lane = tid & 63, tok0 = blockIdx.x * 4;
    for (int tt = 0; tt < 4; ++tt) {
        const int m = tok0 + tt; int t, T;
        if (m < 4096) { t = m & 255; T = 256; } else { t = (m - 4096) & 1023; T = 1024; }
        const float* zc = z + (size_t)m * INC + ZB0;
        for (int c = tid; c < 2688; c += 256) {
            const float cur = zc[c];
            const float prev = t > 0 ? zc[c - INC] : 0.f, next = t < T - 1 ? zc[c + INC] : 0.f;
            zm[tt][c] = cur + (0.5f * (prev + next) - cur) * mu[c];
        }
    }
    __syncthreads();
    for (int idx = tid; idx < 4 * 384; idx += 256) {
        const int tt = idx / 384, j = idx % 384; float v = zm[tt][2304 + j];
        if (j < 128) v = tanhf(v); else if (j >= 256) v = sigmoidf_(v);
        zm[tt][2304 + j] = v;
    }
    __syncthreads();
    for (int jj = 0; jj < 3; ++jj) {
        const int c = tid + 256 * jj, head = c >> 6;
        float accw[2][4], acca[2][4], accg[4];
#pragma unroll
        for (int tt = 0; tt < 4; ++tt) { accw[0][tt] = accw[1][tt] = acca[0][tt] = acca[1][tt] = accg[tt] = 0.f; }
        for (int r = 0; r < 64; ++r) {
#pragma unroll
            for (int d = 0; d < 2; ++d) {
                const float w2v = w2[((size_t)d * 64 + r) * BW + c], a2v = a2[((size_t)d * 64 + r) * BW + c];
#pragma unroll
                for (int tt = 0; tt < 4; ++tt) { accw[d][tt] += zm[tt][2304 + d * 64 + r] * w2v; acca[d][tt] += zm[tt][2432 + d * 64 + r] * a2v; }
            }
        }
        for (int r = 0; r < 128; ++r) {
            const float g2v = g2[(size_t)r * BW + c];
#pragma unroll
            for (int tt = 0; tt < 4; ++tt) accg[tt] += zm[tt][2560 + r] * g2v;
        }
#pragma unroll
        for (int tt = 0; tt < 4; ++tt) {
            const int m = tok0 + tt;
            const float r_ = zm[tt][c], k_ = zm[tt][768 + c], v_ = zm[tt][1536 + c];
            float kkv = k_ * kkw[c];
            const float nrm = sqrtf(wave_sum(kkv * kkv));
            kkv = kkv / fmaxf(nrm, 1e-12f);
            float bon = 0.f;
#pragma unroll
            for (int d = 0; d < 2; ++d) {
                const float wraw = w0[d * BW + c] + accw[d][tt];
                const float dec = __expf(-0.6065306597126334f * sigmoidf_(wraw));
                const float a = sigmoidf_(a0[d * BW + c] + acca[d][tt]);
                const float kd = k_ * (1.f + (a - 1.f) * kaw[c]);
                const size_t o = ((size_t)d * NTOK + m) * BW + c;
                W[o] = dec; KD[o] = kd; Bv[o] = kkv * a;
                bon += r_ * kd * rk[c];
            }
            bon = wave_sum(bon);
            if (lane == 0) BON[m * 12 + head] = bon;
            const size_t o = (size_t)m * BW + c;
            R[o] = r_; V[o] = v_; KK[o] = kkv; GATE[o] = accg[tt];
        }
    }
}

__global__ __launch_bounds__(64) void k_rwkv_scan(const float* R, const float* W, const float* KD, const float* V, const float* KK, const float* Bv,
                                                 const float* state_in, float* Y, float* state_out, int l) {
    const int chain = blockIdx.x, dir = chain & 1, head = (chain >> 1) % 12, seq = chain / 24, lane = threadIdx.x;
    int T, base; float s[64];
    if (seq < 16) {
        T = 256; base = seq * 256;
#pragma unroll
        for (int k = 0; k < 64; ++k) s[k] = 0.f;
    } else {
        const int b = seq - 16; T = 1024; base = 4096 + b * 1024;
        const float* sp = state_in + ((((size_t)(b * 2 + l) * 2 + dir) * 12 + head) * 64 + lane) * 64;
#pragma unroll
        for (int k = 0; k < 64; ++k) s[k] = sp[k];
    }
    for (int step = 0; step < T; ++step) {
        const int t = dir ? T - 1 - step : step, m = base + t;
        const float* rp = R + (size_t)m * BW + head * 64;
        const float* kkp = KK + (size_t)m * BW + head * 64;
        const float* wp = W + ((size_t)dir * NTOK + m) * BW + head * 64;
        const float* kdp = KD + ((size_t)dir * NTOK + m) * BW + head * 64;
        const float* bp = Bv + ((size_t)dir * NTOK + m) * BW + head * 64;
        const float vv = V[(size_t)m * BW + head * 64 + lane];
        float sa = 0.f;
#pragma unroll
        for (int k = 0; k < 64; ++k) sa -= s[k] * kkp[k];
#pragma unroll
        for (int k = 0; k < 64; ++k) s[k] = s[k] * wp[k] + sa * bp[k] + vv * kdp[k];
        float y = 0.f;
#pragma unroll
        for (int k = 0; k < 64; ++k) y += s[k] * rp[k];
        Y[((size_t)dir * NTOK + m) * BW + head * 64 + lane] = y;
    }
    if (seq < 16) {
        float* sp = state_out + ((((size_t)(seq * 2 + l) * 2 + dir) * 12 + head) * 64 + lane) * 64;
#pragma unroll
        for (int k = 0; k < 64; ++k) sp[k] = s[k];
    }
}

__global__ __launch_bounds__(256) void k_rwkv_post(const float* Y, const float* V, const float* GATE, const float* BON, const float* lg, const float* lb, float* o) {
    const int m = blockIdx.x, wave = threadIdx.x >> 6, lane = threadIdx.x & 63;
    for (int head = wave; head < 12; head += 4) {
        const int c = head * 64 + lane; const size_t i = (size_t)m * BW + c;
        const float y = Y[i] + Y[(size_t)NTOK * BW + i];
        const float mean = wave_sum(y) * (1.f / 64.f);
        const float dv = y - mean;
        const float var = wave_sum(dv * dv) * (1.f / 64.f);
        const float out = dv * rsqrtf(var + 64e-5f) * lg[c] + lb[c] + BON[m * 12 + head] * V[i];
        o[(size_t)m * D + 512 + c] = out * GATE[i];
    }
}

#define ZC0 3712
__global__ __launch_bounds__(256) void k_hgrn_prep(const float* z, const float* hlb, int l, float* QS, float* FG) {
    const int m = blockIdx.x;
    for (int c = threadIdx.x; c < 768; c += 256) {
        const float* zr = z + (size_t)m * INC + ZC0;
        QS[(size_t)m * 768 + c] = siluf_(zr[c]);
#pragma unroll
        for (int d = 0; d < 2; ++d) {
            float lbv = 0.f;
            if (l == 1) { const float h0 = hlb[d * 768 + c], h1 = hlb[(2 + d) * 768 + c]; lbv = 1.f / (1.f + __expf(h0 - h1)); }
            FG[((size_t)d * NTOK + m) * 768 + c] = lbv + (1.f - lbv) * sigmoidf_(zr[768 + d * 768 + c]);
        }
    }
}
__global__ __launch_bounds__(128) void k_hgrn_scan(const float* z, const float* QS, const float* FG, const float* state_in, float* HO, float* state_out, int l) {
    const int chain = blockIdx.x, dir = chain & 1, head = (chain >> 1) % 6, seq = chain / 12, tid = threadIdx.x;
    int T, base; float s[128];
    if (seq < 16) {
        T = 256; base = seq * 256;
#pragma unroll
        for (int k = 0; k < 128; ++k) s[k] = 0.f;
    } else {
        const int b = seq - 16; T = 1024; base = 4096 + b * 1024;
        const float* sp = state_in + (((size_t)(b * 2 + l) * 2 + dir) * 6 + head) * 128 * 128 + tid;
#pragma unroll
        for (int k = 0; k < 128; ++k) s[k] = sp[k * 128];
    }
    for (int step = 0; step < T; ++step) {
        const int t = dir ? T - 1 - step : step, m = base + t;
        const float* qp = QS + (size_t)m * 768 + head * 128;
        const float* fp = FG + ((size_t)dir * NTOK + m) * 768 + head * 128;
        const float vv = z[(size_t)m * INC + ZC0 + 2304 + head * 128 + tid];
        float o = 0.f;
#pragma unroll
        for (int k = 0; k < 128; ++k) { const float f = fp[k]; s[k] = f * s[k] + (1.f - f) * vv; o += s[k] * qp[k]; }
        HO[((size_t)dir * NTOK + m) * 768 + head * 128 + tid] = o;
    }
    if (seq < 16) {
        float* sp = state_out + (((size_t)(seq * 2 + l) * 2 + dir) * 6 + head) * 128 * 128 + tid;
#pragma unroll
        for (int k = 0; k < 128; ++k) sp[k * 128] = s[k];
    }
}
__global__ __launch_bounds__(128) void k_hgrn_post(const float* z, const float* HO, const float* gn, float* o) {
    __shared__ float red[2];
    const int m = blockIdx.x, tid = threadIdx.x;
    for (int head = 0; head < 6; ++head) {
        const size_t i = (size_t)m * 768 + head * 128 + tid;
        const float v = HO[i] + HO[(size_t)NTOK * 768 + i];
        const float ss = wave_sum(v * v);
        __syncthreads();
        if ((tid & 63) == 0) red[tid >> 6] = ss;
        __syncthreads();
        const float rstd = rsqrtf((red[0] + red[1]) * (1.f / 128.f) + 1e-6f);
        const float g = z[(size_t)m * INC + ZC0 + 3072 + head * 128 + tid];
        o[(size_t)m * D + 1280 + head * 128 + tid] = v * rstd * gn[tid] * siluf_(g);
    }
}

extern "C" void kernel_launch(void* const* d_in, const int* in_sizes, int n_in, void* d_out, int out_size, void* d_ws, size_t ws_size, hipStream_t stream) {
    const float* x_prompt = (const float*)d_in[0]; const float* x_sample = (const float*)d_in[1];
    const float* state_rwkv = (const float*)d_in[2]; const float* state_hgrn = (const float*)d_in[3];
    const float* c = (const float*)d_in[4]; const float* c_ctx = (const float*)d_in[5];
    const float* norm_g = (const float*)d_in[6]; const float* w_mod = (const float*)d_in[7]; const float* b_mod = (const float*)d_in[8];
    const float* ffn_w1 = (const float*)d_in[9]; const float* ffn_w3 = (const float*)d_in[10]; const float* ffn_w2 = (const float*)d_in[11];
    const float* w_in = (const float*)d_in[12]; const float* w_out = (const float*)d_in[13];
    const float* mlp_ng = (const float*)d_in[14]; const float* mlp_ws = (const float*)d_in[15]; const float* mlp_bs = (const float*)d_in[16];
    const float* r_mu = (const float*)d_in[17]; const float* r_w0 = (const float*)d_in[18]; const float* r_w2 = (const float*)d_in[19];
    const float* r_a0 = (const float*)d_in[20]; const float* r_a2 = (const float*)d_in[21]; const float* r_g2 = (const float*)d_in[22];
    const float* r_kk = (const float*)d_in[23]; const float* r_ka = (const float*)d_in[24]; const float* r_rk = (const float*)d_in[25];
    const float* r_lg = (const float*)d_in[26]; const float* r_lb = (const float*)d_in[27];
    const float* h_lb = (const float*)d_in[28]; const float* h_gn = (const float*)d_in[29]; const float* final_g = (const float*)d_in[30];

    float* out = (float*)d_out;
    float* x = out;
    float* out_srw = out + (size_t)NTOK * D;
    float* out_shg = out_srw + (size_t)16 * 2 * 2 * 12 * 64 * 64;

    float* ws = (float*)d_ws; size_t off = 0;
    auto take = [&](size_t n) { float* p = ws + off; off += (n + 63) & ~(size_t)63; return p; };
    float* MODP = take((size_t)16 * 2 * 3 * NMODC);
    float* MOD = take((size_t)2 * 3 * NMODC);
    float* H = take((size_t)NTOK * D);
    float* G = take((size_t)NTOK * DFF);
    float* Z = take((size_t)NTOK * INC);
    float* O = take((size_t)NTOK * D);
    float* R = take((size_t)NTOK * BW); float* V = take((size_t)NTOK * BW); float* KK = take((size_t)NTOK * BW); float* GATE = take((size_t)NTOK * BW);
    float* W = take((size_t)2 * NTOK * BW); float* KD = take((size_t)2 * NTOK * BW); float* Bv = take((size_t)2 * NTOK * BW);
    float* BON = take((size_t)NTOK * 12);
    float* Y = take((size_t)2 * NTOK * BW);
    float* QS = take((size_t)NTOK * 768); float* FG = take((size_t)2 * NTOK * 768); float* HO = take((size_t)2 * NTOK * 768);

    hipMemcpyAsync(x, x_prompt, (size_t)4096 * D * 4, hipMemcpyDeviceToDevice, stream);
    hipMemcpyAsync(x + (size_t)4096 * D, x_sample, (size_t)2048 * D * 4, hipMemcpyDeviceToDevice, stream);
    k_mod_partial<<<dim3(NMODC / 256, 2, 16), 256, 0, stream>>>(c, c_ctx, w_mod, MODP);
    k_mod_reduce<<<dim3(NMODC / 256, 2, 3), 256, 0, stream>>>(MODP, b_mod, MOD);

    for (int l = 0; l < 2; ++l) {
        const float* mod = MOD + (size_t)l * 3 * NMODC;
        k_norm_mod<<<NTOK, 256, 0, stream>>>(x, norm_g + (size_t)(l * 3 + 0) * D, mod, 0, H);
        k_gemm<1><<<dim3(DFF / 64, NTOK / 64), 256, 0, stream>>>(H, D, ffn_w1 + (size_t)(l * 2 + 0) * D * DFF, ffn_w3 + (size_t)(l * 2 + 0) * D * DFF, DFF, D, G, DFF, nullptr, 0.f);
        k_gemm<2><<<dim3(D / 64, NTOK / 64), 256, 0, stream>>>(G, DFF, ffn_w2 + (size_t)(l * 2 + 0) * DFF * D, nullptr, D, DFF, x, D, mod + 2 * D, 0.5f);
        k_norm_mod<<<NTOK, 256, 0, stream>>>(x, norm_g + (size_t)(l * 3 + 1) * D, mod, 3, H);
        k_gemm<0><<<dim3(INC / 64, NTOK / 64), 256, 0, stream>>>(H, D, w_in + (size_t)l * D * INC, nullptr, INC, D, Z, INC, nullptr, 0.f);
        k_chunk_mlp<<<dim3(NTOK / 128, 4), 256, 0, stream>>>(Z, mlp_ng + (size_t)l * 512, mlp_ws + (size_t)l * 4 * 128 * 128, mlp_bs + (size_t)l * 512, O);
        k_rwkv_prep<<<NTOK / 4, 256, 0, stream>>>(Z, r_mu + (size_t)l * 2688, r_w0 + (size_t)l * 2 * BW, r_w2 + (size_t)l * 2 * 64 * BW, r_a0 + (size_t)l * 2 * BW, r_a2 + (size_t)l * 2 * 64 * BW,
                                                  r_g2 + (size_t)l * 128 * BW, r_kk + (size_t)l * BW, r_ka + (size_t)l * BW, r_rk + (size_t)l * BW, R, V, KK, GATE, W, KD, Bv, BON);
        k_rwkv_scan<<<18 * 24, 64, 0, stream>>>(R, W, KD, V, KK, Bv, state_rwkv, Y, out_srw, l);
        k_rwkv_post<<<NTOK, 256, 0, stream>>>(Y, V, GATE, BON, r_lg + (size_t)l * BW, r_lb + (size_t)l * BW, O);
        k_hgrn_prep<<<NTOK, 256, 0, stream>>>(Z, h_lb, l, QS, FG);
        k_hgrn_scan<<<18 * 12, 128, 0, stream>>>(Z, QS, FG, state_hgrn, HO, out_shg, l);
        k_hgrn_post<<<NTOK, 128, 0, stream>>>(Z, HO, h_gn + (size_t)l * 128, O);
        k_gemm<2><<<dim3(D / 64, NTOK / 64), 256, 0, stream>>>(O, D, w_out + (size_t)l * D * D, nullptr, D, D, x, D, mod + 5 * D, 1.0f);
        k_norm_mod<<<NTOK, 256, 0, stream>>>(x, norm_g + (size_t)(l * 3 + 2) * D, mod, 6, H);
        k_gemm<1><<<dim3(DFF / 64, NTOK / 64), 256, 0, stream>>>(H, D, ffn_w1 + (size_t)(l * 2 + 1) * D * DFF, ffn_w3 + (size_t)(l * 2 + 1) * D * DFF, DFF, D, G, DFF, nullptr, 0.f);
        k_gemm<2><<<dim3(D / 64, NTOK / 64), 256, 0, stream>>>(G, DFF, ffn_w2 + (size_t)(l * 2 + 1) * DFF * D, nullptr, D, DFF, x, D, mod + 8 * D, 0.5f);
    }
    k_norm_mod<<<NTOK, 256, 0, stream>>>(x, final_g, nullptr, 0, x);
}
```

```cpp
#include <hip/hip_runtime.h>
#include <cstdio>
#include <cstdint>
namespace pg8 {
#define PG8_LAS __attribute__((address_space(3)))
typedef unsigned short bf16_t;
typedef short bf16x8 __attribute__((ext_vector_type(8)));
typedef float f32x4 __attribute__((ext_vector_type(4)));
typedef unsigned u32x4 __attribute__((ext_vector_type(4)));
constexpr int BM = 256, BK = 64, HALF = 128, HTB = HALF * BK * 2  , STAGE_BYTES = 8 * HTB, NXCD = 8, WGM = 8;

__host__ __device__ __forceinline__ int lds_byte(int r, int c) { const int st = (r >> 4) * 2 + (c >> 5), rr = r & 15, cc = c & 31, ob = rr * 64 + cc * 2; return st * 1024 + (ob ^ (((ob >> 9) & 1) << 5)); }
__host__ __device__ __forceinline__ void stage_rc(int b, int& R, int& C) { const int st = b / 1024, sb = b % 1024, swz = sb ^ (((sb >> 9) & 1) << 5); R = (st >> 1) * 16 + swz / 64; C = (st & 1) * 32 + (swz % 64) / 2; }
__host__ __device__ __forceinline__ int perm32(int rho) { const int n = rho >> 4, i = rho & 15; return 8 * (i >> 2) + 4 * n + (i & 3); }

struct Unit { int pm, pn; };
struct Gemm { const bf16_t* A; const bf16_t* Bt; int M, N, K; };

struct StaticOrder {
    int nM, nN, nwg, G, c;
    __host__ __device__ void init(int M, int N, int G_, int c_) { nM = M / BM; nN = N / BM; nwg = nM * nN; G = G_; c = c_; }
    __host__ __device__ bool next(int i, Unit& u) const {
        const long L = (long)i * G + c; if (L >= nwg) return false;
        int wgid = (int)L; { const int q = nwg / NXCD, r = nwg % NXCD, xcd = wgid % NXCD, off = wgid / NXCD; wgid = (xcd < r ? xcd * (q + 1) : r * (q + 1) + (xcd - r) * q) + off; }
        const int nig = WGM * nN, gid = wgid / nig, fm = gid * WGM, gsz = (nM - fm) < WGM ? (nM - fm) : WGM;
        u.pm = fm + ((wgid % nig) % gsz); u.pn = (wgid % nig) / gsz; return true;
    }
    __device__ __forceinline__ void a_ready(const Unit&) const {}
    __device__ __forceinline__ void done(const Unit&) const {}
};

__device__ __forceinline__ unsigned cvt_pk_bf16(float lo, float hi) { unsigned r; asm volatile("v_cvt_pk_bf16_f32 %0, %1, %2" : "=v"(r) : "v"(lo), "v"(hi)); return r; }
typedef float f32x2 __attribute__((ext_vector_type(2)));
__device__ __forceinline__ float silu_f(float x) { return x / (1.f + __expf(-x)); }
struct EpiSwiglu {
    static constexpr bool PERM = true, AFTER_DRAIN = false;
    bf16_t* O; int ldc;
    __device__ __forceinline__ void operator()(const f32x4 (&acc)[2][2][4][2], const Unit& u, int wr, int wc, int fr, int fq) const {
        const int row0 = u.pm * BM + wr * 64 + fr, col0 = u.pn * HALF + wc * 32 + 8 * fq;
#pragma unroll
        for (int ai = 0; ai < 2; ++ai)
#pragma unroll
            for (int m = 0; m < 4; ++m) { bf16_t* rowp = O + (size_t)(row0 + ai * HALF + m * 16) * ldc + col0;
                const f32x4 a0 = acc[ai][0][m][0], a1 = acc[ai][0][m][1], g0 = acc[ai][1][m][0], g1 = acc[ai][1][m][1];
                u32x4 w; w.x = cvt_pk_bf16(silu_f(a0[0]) * g0[0], silu_f(a0[1]) * g0[1]); w.y = cvt_pk_bf16(silu_f(a0[2]) * g0[2], silu_f(a0[3]) * g0[3]);
                w.z = cvt_pk_bf16(silu_f(a1[0]) * g1[0], silu_f(a1[1]) * g1[1]); w.w = cvt_pk_bf16(silu_f(a1[2]) * g1[2], silu_f(a1[3]) * g1[3]);
                *(u32x4*)rowp = w; }
    }
};
struct EpiResid {
    static constexpr bool PERM = false, AFTER_DRAIN = false;
    float* X; int ldc; const float* gate_base; int gate_stride; float scale;
    __device__ __forceinline__ void operator()(const f32x4 (&acc)[2][2][4][2], const Unit& u, int wr, int wc, int fr, int fq) const {
        const int rt = u.pm * BM; const int cond = rt < 4096 ? 0 : 1 + ((rt - 4096) >> 10);
        const float* gate = gate_base + (size_t)cond * gate_stride;
        const int col0 = u.pn * BM + wc * 32 + 4 * fq;
#pragma unroll
        for (int bj = 0; bj < 2; ++bj)
#pragma unroll
            for (int n = 0; n < 2; ++n) { const int c = col0 + bj * HALF + n * 16; const f32x4 gv = *(const f32x4*)(gate + c) * scale;
#pragma unroll
                for (int ai = 0; ai < 2; ++ai)
#pragma unroll
                    for (int m = 0; m < 4; ++m) { float* p = X + (size_t)(rt + ai * HALF + wr * 64 + m * 16 + fr) * ldc + c;
                        const f32x4 old = *(const f32x4*)p; *(f32x4*)p = old + gv * acc[ai][bj][m][n]; } }
    }
};
struct EpiStoreF32 {
    static constexpr bool PERM = false, AFTER_DRAIN = false;
    float* Z; int ldc;
    __device__ __forceinline__ void operator()(const f32x4 (&acc)[2][2][4][2], const Unit& u, int wr, int wc, int fr, int fq) const {
        const int col0 = u.pn * BM + wc * 32 + 4 * fq;
#pragma unroll
        for (int ai = 0; ai < 2; ++ai)
#pragma unroll
            for (int m = 0; m < 4; ++m) { float* rowp = Z + (size_t)(u.pm * BM + ai * HALF + wr * 64 + m * 16 + fr) * ldc + col0;
#pragma unroll
                for (int bj = 0; bj < 2; ++bj)
#pragma unroll
                    for (int n = 0; n < 2; ++n) *(f32x4*)(rowp + bj * HALF + n * 16) = acc[ai][bj][m][n]; }
    }
};
template <class Epi, class Sched, bool ALIGN_EPI = false, bool SP2 = false>
__device__ __forceinline__ void gemm_phase(PG8_LAS unsigned char* lds, const Gemm g, const Sched& S, const Epi& E) {
    int tid0_ = threadIdx.x; asm volatile("" : "+v"(tid0_));
    const int tid = tid0_, wid = __builtin_amdgcn_readfirstlane(tid >> 6), lane = tid & 63, wr = wid >> 2, wc = wid & 3, fr = lane & 15, fq = lane >> 4;
    const int K = g.K, nt = K / BK;
    unsigned voffA[2], voffB[2];
#pragma unroll
    for (int i = 0; i < 2; ++i) { int R, C; stage_rc(tid * 16 + i * 8192, R, C); const int Rb = Epi::PERM ? ((R & ~31) + perm32(R & 31)) : R;
        voffA[i] = (unsigned)(R * K + C) * 2u; voffB[i] = (unsigned)(Rb * K + C) * 2u; }
    const size_t kstep = (size_t)(BK * 2);
    const size_t hstep = (size_t)HALF * K * 2;
    const size_t tstep = 2 * hstep;
    const unsigned ldsw = (unsigned)wid * 1024u;
    const int aoff = lds_byte(wr * 64 + fr, fq * 8), boff = lds_byte(wc * 32 + fr, fq * 8);
#define PG8_SA(b, h) (((b) * 2 + (h)) * HTB)
#define PG8_SB(b, h) ((4 + (b) * 2 + (h)) * HTB)
#define PG8_STAGE(bufoff, gbase, voff) do { _Pragma("unroll") for (int _i = 0; _i < 2; ++_i) \
        __builtin_amdgcn_global_load_lds((const unsigned*)((const char*)(gbase) + (voff)[_i]), (PG8_LAS unsigned*)(lds + (bufoff) + ldsw + _i * 8192), 16, 0, 0); } while (0)
#define PG8_LDA(dst, b, h) do { _Pragma("unroll") for (int m = 0; m < 4; ++m) _Pragma("unroll") for (int k = 0; k < 2; ++k) dst[m][k] = *(const PG8_LAS bf16x8*)(lds + PG8_SA(b, h) + aoff + m * 2048 + k * 1024); } while (0)
#define PG8_LDB(dst, b, h) do { _Pragma("unroll") for (int n = 0; n < 2; ++n) _Pragma("unroll") for (int k = 0; k < 2; ++k) dst[n][k] = *(const PG8_LAS bf16x8*)(lds + PG8_SB(b, h) + boff + n * 2048 + k * 1024); } while (0)
#define PG8_MMA(ai, bj, At, Bt) do { __builtin_amdgcn_s_setprio(1); _Pragma("unroll") for (int m = 0; m < 4; ++m) _Pragma("unroll") for (int n = 0; n < 2; ++n) _Pragma("unroll") for (int k = 0; k < 2; ++k) \
        acc[ai][bj][m][n] = __builtin_amdgcn_mfma_f32_16x16x32_bf16(Bt[n][k], At[m][k], acc[ai][bj][m][n], 0, 0, 0); __builtin_amdgcn_s_setprio(0); } while (0)
#define PG8_WAIT_V(n) asm volatile("s_waitcnt vmcnt(" #n ")" ::: "memory")
#define PG8_WAIT_L(n) asm volatile("s_waitcnt lgkmcnt(" #n ")" ::: "memory")
#define PG8_BAR __builtin_amdgcn_s_barrier()
#define PG8_SCHED __builtin_amdgcn_sched_barrier(0)
    Unit cur, nxt; int ui = 0;
    if (!S.next(0, cur)) return;
    f32x4 acc[2][2][4][2];
#pragma unroll
    for (int a = 0; a < 2; ++a)
#pragma unroll
        for (int b = 0; b < 2; ++b)
#pragma unroll
            for (int m = 0; m < 4; ++m)
#pragma unroll
                for (int n = 0; n < 2; ++n) acc[a][b][m][n] = (f32x4){0.f, 0.f, 0.f, 0.f};
    bf16x8 At[4][2], B0[2][2], B1[2][2];
    const char* cA = (const char*)g.A + (size_t)cur.pm * tstep; const char* cB = (const char*)g.Bt + (size_t)cur.pn * tstep;
    S.a_ready(cur);
    if constexpr (SP2) {
        PG8_STAGE(PG8_SB(0, 0), cB, voffB); PG8_STAGE(PG8_SB(0, 1), cB + hstep, voffB); PG8_STAGE(PG8_SA(0, 0), cA, voffA); PG8_STAGE(PG8_SA(0, 1), cA + hstep, voffA);
        if (wr == 1) PG8_BAR;
        PG8_WAIT_V(2); PG8_BAR;
        PG8_STAGE(PG8_SB(1, 0), cB + kstep, voffB); PG8_STAGE(PG8_SA(1, 0), cA + kstep, voffA); PG8_STAGE(PG8_SB(1, 1), cB + hstep + kstep, voffB);
        PG8_WAIT_V(6); PG8_BAR;
    } else {
        PG8_STAGE(PG8_SB(0, 0), cB, voffB); PG8_STAGE(PG8_SA(0, 0), cA, voffA); PG8_STAGE(PG8_SB(0, 1), cB + hstep, voffB); PG8_STAGE(PG8_SA(0, 1), cA + hstep, voffA);
        if (wr == 1) PG8_BAR;
        PG8_WAIT_V(4); PG8_BAR;
        PG8_STAGE(PG8_SB(1, 0), cB + kstep, voffB); PG8_STAGE(PG8_SA(1, 0), cA + kstep, voffA); PG8_STAGE(PG8_SB(1, 1), cB + hstep + kstep, voffB);
        PG8_WAIT_V(6); PG8_BAR;
    }
    for (;;) {
        const bool has_next = S.next(ui + 1, nxt);
        const char* nA = has_next ? (const char*)g.A + (size_t)nxt.pm * tstep : cA; const char* nB = has_next ? (const char*)g.Bt + (size_t)nxt.pn * tstep : cB;
        for (int t = 0; t < nt; t += 2) {
            const bool last = (t == nt - 2);
            const char* a1 = cA + (size_t)(t + 1) * kstep;
            const char* a2 = last ? nA : cA + (size_t)(t + 2) * kstep; const char* b2 = last ? nB : cB + (size_t)(t + 2) * kstep;
            const char* a3 = a2 + kstep; const char* b3 = b2 + kstep;
            if (last && has_next) S.a_ready(nxt);
            if constexpr (SP2) {
            PG8_LDB(B0, 0, 0); PG8_LDB(B1, 0, 1); PG8_SCHED; PG8_LDA(At, 0, 0); PG8_STAGE(PG8_SA(1, 1), a1 + hstep, voffA);
            PG8_WAIT_V(8); PG8_WAIT_L(0); PG8_BAR; PG8_MMA(0, 0, At, B0); PG8_MMA(0, 1, At, B1); PG8_BAR; PG8_SCHED;
            PG8_LDA(At, 0, 1); PG8_STAGE(PG8_SB(0, 0), b2, voffB); PG8_STAGE(PG8_SB(0, 1), b2 + hstep, voffB); PG8_STAGE(PG8_SA(0, 0), a2, voffA);
            PG8_WAIT_V(8); PG8_WAIT_L(0); PG8_BAR; PG8_MMA(1, 0, At, B0); PG8_MMA(1, 1, At, B1); PG8_BAR; PG8_SCHED;
            PG8_LDB(B0, 1, 0); PG8_LDB(B1, 1, 1); PG8_SCHED; PG8_LDA(At, 1, 0); PG8_STAGE(PG8_SA(0, 1), a2 + hstep, voffA);
            PG8_WAIT_V(8); PG8_WAIT_L(0); PG8_BAR; PG8_MMA(0, 0, At, B0); PG8_MMA(0, 1, At, B1); PG8_BAR; PG8_SCHED;
            PG8_LDA(At, 1, 1); PG8_STAGE(PG8_SB(1, 0), b3, voffB); PG8_STAGE(PG8_SB(1, 1), b3 + hstep, voffB); PG8_STAGE(PG8_SA(1, 0), a3, voffA);
            PG8_WAIT_V(8); PG8_WAIT_L(0); PG8_BAR; PG8_MMA(1, 0, At, B0); PG8_MMA(1, 1, At, B1); PG8_BAR; PG8_SCHED;
            } else {
            PG8_LDB(B0, 0, 0); PG8_SCHED; PG8_LDA(At, 0, 0); PG8_STAGE(PG8_SA(1, 1), a1 + hstep, voffA);
            PG8_WAIT_L(8); PG8_BAR; PG8_WAIT_L(0); PG8_MMA(0, 0, At, B0); PG8_BAR; PG8_SCHED;
            PG8_LDB(B1, 0, 1); PG8_STAGE(PG8_SB(0, 0), b2, voffB);
            PG8_BAR; PG8_WAIT_L(0); PG8_MMA(0, 1, At, B1); PG8_BAR;
            PG8_LDA(At, 0, 1); PG8_STAGE(PG8_SA(0, 0), a2, voffA);
            PG8_BAR; PG8_WAIT_L(0); PG8_MMA(1, 0, At, B0); PG8_BAR; PG8_SCHED;
            PG8_STAGE(PG8_SB(0, 1), b2 + hstep, voffB);
            PG8_WAIT_V(6); PG8_BAR; PG8_MMA(1, 1, At, B1); PG8_BAR;
            PG8_LDB(B0, 1, 0); PG8_SCHED; PG8_LDA(At, 1, 0); PG8_STAGE(PG8_SA(0, 1), a2 + hstep, voffA);
            PG8_WAIT_L(8); PG8_BAR; PG8_WAIT_L(0); PG8_MMA(0, 0, At, B0); PG8_BAR; PG8_SCHED;
            PG8_LDB(B1, 1, 1); PG8_STAGE(PG8_SB(1, 0), b3, voffB);
            PG8_BAR; PG8_WAIT_L(0); PG8_MMA(0, 1, At, B1); PG8_BAR;
            PG8_LDA(At, 1, 1); PG8_STAGE(PG8_SA(1, 0), a3, voffA);
            PG8_BAR; PG8_WAIT_L(0); PG8_MMA(1, 0, At, B0); PG8_BAR; PG8_SCHED;
            PG8_STAGE(PG8_SB(1, 1), b3 + hstep, voffB);
            PG8_WAIT_V(6); PG8_BAR; PG8_MMA(1, 1, At, B1); PG8_BAR;
            }
        }
        if constexpr (ALIGN_EPI) { if (wr == 0) PG8_BAR; }
        if constexpr (!Epi::AFTER_DRAIN) { E(acc, cur, wr, wc, fr, fq); S.done(cur); }
        if (!has_next) break;
#pragma unroll
        for (int a = 0; a < 2; ++a)
#pragma unroll
            for (int b = 0; b < 2; ++b)
#pragma unroll
                for (int m = 0; m < 4; ++m)
#pragma unroll
                    for (int n = 0; n < 2; ++n) acc[a][b][m][n] = (f32x4){0.f, 0.f, 0.f, 0.f};
        cur = nxt; cA = nA; cB = nB; ++ui;
        if constexpr (ALIGN_EPI) { if (wr == 1) PG8_BAR; }
    }
    PG8_WAIT_V(0);
    if constexpr (!ALIGN_EPI) { if (wr == 0) PG8_BAR; }
    PG8_BAR;
    if constexpr (Epi::AFTER_DRAIN) { E.fused(acc, cur, wr, wc, fr, fq, lds, wid, lane); S.done(cur); }
#undef PG8_SA
#undef PG8_SB
#undef PG8_STAGE
#undef PG8_LDA
#undef PG8_LDB
#undef PG8_MMA
#undef PG8_WAIT_V
#undef PG8_WAIT_L
#undef PG8_BAR
#undef PG8_SCHED
}
}
#define GAS __attribute__((address_space(1)))
#define LAS __attribute__((address_space(3)))
typedef unsigned short bf16;
typedef unsigned v4u __attribute__((ext_vector_type(4)));
typedef float f32x4 __attribute__((ext_vector_type(4)));
typedef short bf16x8 __attribute__((ext_vector_type(8)));
typedef GAS unsigned gu32;
typedef GAS unsigned long long gu64;
#define RLX_AGENT __ATOMIC_RELAXED, __HIP_MEMORY_SCOPE_AGENT
#define LDS_WAIT() asm volatile("s_waitcnt lgkmcnt(0)" ::: "memory")
#define VM_WAIT() asm volatile("s_waitcnt vmcnt(0)" ::: "memory")
__device__ __forceinline__ unsigned long long rt() { return __builtin_amdgcn_s_memrealtime(); }
__device__ __forceinline__ unsigned f2bf(float f) { unsigned u = __builtin_bit_cast(unsigned, f); return (u + 0x7fffu + ((u >> 16) & 1u)) >> 16; }
__device__ __forceinline__ unsigned pk2(float lo, float hi) { return f2bf(lo) | (f2bf(hi) << 16); }
#define XB_TMO      128
#define XB_XCNT(j)  (256  + 64 * (j))
#define XB_XSUB(j)  (1280 + 64 * (j))
#define XB_XGEN(j)  (2304 + 64 * (j))
#define XB_TOP      3328
#define XB_TOPGEN   3392
#define XCD_BAR_WORDS 3456
#define XB_SPIN_CAP (1u << 18)

__device__ __forceinline__ unsigned xb_ld(unsigned* p)              { return __hip_atomic_load(p, __ATOMIC_RELAXED, __HIP_MEMORY_SCOPE_AGENT); }
__device__ __forceinline__ unsigned xb_add(unsigned* p, unsigned v) { return __hip_atomic_fetch_add(p, v, __ATOMIC_RELAXED, __HIP_MEMORY_SCOPE_AGENT); }
__device__ __forceinline__ unsigned xb_xcc_id() { return (unsigned)__builtin_amdgcn_s_getreg((3 << 11) | 20) & 0xFu; }
#define XB_SPIN(cond, bar) do { unsigned _sp = 0; while (cond) { __builtin_amdgcn_s_sleep(1); \
    if ((++_sp & 255u) == 0u) { if (xb_ld(&(bar)[XB_TMO])) break; if (_sp > XB_SPIN_CAP) { atomicAdd(&(bar)[XB_TMO], 1u); break; } } } } while (0)

struct XcdBarrier {
    unsigned* bar; unsigned x;
    volatile LAS unsigned* st;
};

__device__ __forceinline__ XcdBarrier xcd_barrier_post(unsigned* bar, volatile LAS unsigned* st) {
    XcdBarrier b; b.bar = bar; b.x = xb_xcc_id(); b.st = st;
    if (threadIdx.x == 0) (void)xb_add(&bar[XB_XCNT(b.x)], 1u);
    return b;
}
__device__ __forceinline__ void xcd_barrier_complete(unsigned* bar, unsigned x, unsigned& nloc, unsigned& nx) {
    const unsigned G = gridDim.x * gridDim.y * gridDim.z;
    unsigned sum, cnt, mine, sp = 0u;
    for (;;) {
        sum = 0u; cnt = 0u; mine = 0u;
#pragma unroll
        for (unsigned j = 0; j < 16; ++j) { const unsigned c = xb_ld(&bar[XB_XCNT(j)]); sum += c; cnt += (c > 0u) ? 1u : 0u; mine = (j == x) ? c : mine; }
        if (sum == G) break;
        __builtin_amdgcn_s_sleep(1);
        if ((++sp & 255u) == 0u) { if (xb_ld(&bar[XB_TMO])) break; if (sp > XB_SPIN_CAP) { atomicAdd(&bar[XB_TMO], 1u); break; } }
    }
    nloc = mine > 0u ? mine : 1u; nx = cnt > 0u ? cnt : 1u;
}

__device__ __forceinline__ void xcd_barrier(const XcdBarrier& b) {
    asm volatile("s_waitcnt vmcnt(0)" ::: "memory");
    __syncthreads();
    if (threadIdx.x == 0) {
        unsigned* bar = b.bar;
        __builtin_amdgcn_s_waitcnt(0);
        unsigned nloc = b.st[0], nx = b.st[1];
        if (nloc == 0u) { xcd_barrier_complete(bar, b.x, nloc, nx); b.st[0] = nloc; b.st[1] = nx; }
        const unsigned old = xb_add(&bar[XB_XSUB(b.x)], 1u);
        const unsigned gen = old / nloc;
        if (old + 1u == (gen + 1u) * nloc) {
            __builtin_amdgcn_fence(__ATOMIC_RELEASE, "agent");
            asm volatile("s_waitcnt vmcnt(0)" ::: "memory");
            const unsigned og = xb_add(&bar[XB_TOP], 1u);
            const unsigned tg = og / nx;
            if (og + 1u == (tg + 1u) * nx) xb_add(&bar[XB_TOPGEN], 1u);
            else XB_SPIN(xb_ld(&bar[XB_TOPGEN]) == tg, bar);
            __builtin_amdgcn_fence(__ATOMIC_ACQUIRE, "agent");
            xb_add(&bar[XB_XGEN(b.x)], 1u);
            asm volatile("s_waitcnt vmcnt(0)" ::: "memory");
        } else {
            XB_SPIN(xb_ld(&bar[XB_XGEN(b.x)]) == gen, bar);
            __builtin_amdgcn_fence(__ATOMIC_ACQUIRE, "agent");
            asm volatile("s_waitcnt vmcnt(0)" ::: "memory");
        }
    }
    __syncthreads();
}
constexpr int NWAVES = 8;
#ifndef MK_REP_S
#define MK_REP_S -1
#endif
#ifndef MK_AMP
#define MK_AMP -1
#endif
#ifndef MK_AMPK
#define MK_AMPK 4
#endif
#ifndef MK_PER_PHASE
#define MK_PER_PHASE 0
#endif
constexpr int DM = 2048, NTOK = 6144, DFF = 5632, INC = 7552, ZLD = 7680, BWD = 768, NMODC = 18432;
constexpr int ZB0 = 1024, ZC0 = 3712;
constexpr int N_PHASES = 26;
constexpr size_t MiB = 1u << 20;
constexpr size_t WS_CTL = 0, CTL_ZERO_BYTES = 1 * MiB;
constexpr size_t WS_MOD = 1 * MiB;
constexpr size_t WS_W13 = 2 * MiB, SZ_W13 = 44 * MiB;
constexpr size_t WS_W2 = WS_W13 + 4 * SZ_W13, SZ_W2 = 22 * MiB;
constexpr size_t WS_WIN = WS_W2 + 4 * SZ_W2, SZ_WIN = 30 * MiB;
constexpr size_t WS_WOUT = WS_WIN + 2 * SZ_WIN, SZ_WOUT = 8 * MiB;
constexpr size_t WS_H = WS_WOUT + 2 * SZ_WOUT;
constexpr size_t WS_G = WS_H + 24 * MiB;
constexpr size_t WS_Z = WS_G + 66 * MiB;
constexpr size_t WS_O = WS_Z + 180 * MiB;
constexpr size_t SZ_T = 18 * MiB;
constexpr size_t WS_R = WS_O + 24 * MiB, WS_V = WS_R + SZ_T, WS_KK = WS_V + SZ_T, WS_GATE = WS_KK + SZ_T;
constexpr size_t WS_W = WS_GATE + SZ_T, WS_KD = WS_W + 2 * SZ_T, WS_BV = WS_KD + 2 * SZ_T, WS_Y = WS_BV + 2 * SZ_T;
constexpr size_t WS_BON = WS_Y + 2 * SZ_T;
constexpr size_t WS_QS = WS_BON + 1 * MiB, WS_FG = WS_QS + SZ_T, WS_HO = WS_FG + 2 * SZ_T;
constexpr size_t WS_HF = WS_HO + 2 * SZ_T, WS_EB = WS_HF + 72 * MiB, WS_LW = WS_EB + 2 * MiB, WS_END = WS_LW + 2 * MiB;
constexpr int CW_BAR = 4096;
constexpr int RING_BYTES = 135168;
constexpr int LDSCTL_OFF = RING_BYTES, MISC_OFF = LDSCTL_OFF + 320;
constexpr int LDS_BYTES = 147456;

__device__ __forceinline__ float sigmoid_f(float x) { return 1.f / (1.f + __expf(-x)); }
__device__ __forceinline__ float silu_f(float x) { return x / (1.f + __expf(-x)); }
__device__ __forceinline__ float gelu_tanh(float x) { const float u = 0.7978845608028654f * (x + 0.044715f * x * x * x); return 0.5f * x * (1.f + tanhf(u)); }
__device__ __forceinline__ float wave_sum(float v) {
#pragma unroll
    for (int o = 1; o < 64; o <<= 1) v += __shfl_xor(v, o);
    return v;
}
#define WG_SYNC() do { asm volatile("s_waitcnt vmcnt(0) lgkmcnt(0)" ::: "memory"); __builtin_amdgcn_s_barrier(); asm volatile("" ::: "memory"); } while (0)

__device__ __forceinline__ void conv_item(const float* W, int K, int N, bf16* WT, int mode, LAS float* scr, int item, int lane) {
    const int nblk = N / 32, kb = item / nblk, nb = item % nblk, k0 = 64 * kb, n0 = 32 * nb;
#pragma unroll 8
    for (int i = 0; i < 32; ++i) { const int kk = 2 * i + (lane >> 5); scr[kk * 33 + (lane & 31)] = W[(size_t)(k0 + kk) * N + n0 + (lane & 31)]; }
    LDS_WAIT(); asm volatile("" ::: "memory");
    const int rowbase = mode == 0 ? n0 : (256 * (n0 >> 7) + (n0 & 127) + (mode == 2 ? 128 : 0));
    const int c = lane & 7;
#pragma unroll
    for (int j = 0; j < 4; ++j) { const int n = (lane >> 3) + 8 * j; const LAS float* s = scr + (8 * c) * 33 + n;
        v4u o; o.x = pk2(s[0 * 33], s[1 * 33]); o.y = pk2(s[2 * 33], s[3 * 33]); o.z = pk2(s[4 * 33], s[5 * 33]); o.w = pk2(s[6 * 33], s[7 * 33]);
        *(GAS v4u*)(WT + (size_t)(rowbase + n) * K + k0 + 8 * c) = o; }
    LDS_WAIT(); asm volatile("" ::: "memory");
}

struct Args { const float* in[31]; float* out; unsigned char* ws; int ph_lo, ph_hi, li, pad; };

__device__ __forceinline__ void conv_ffn(const Args& A, int l, int i, LAS float* scr, int gw, int NGW, int lane) {
    constexpr int I_13 = (DM / 64) * (DFF / 32), I_2 = (DFF / 64) * (DM / 32);
    const float* w1 = A.in[9] + (size_t)(l * 2 + i) * DM * DFF; const float* w3 = A.in[10] + (size_t)(l * 2 + i) * DM * DFF; const float* w2 = A.in[11] + (size_t)(l * 2 + i) * DFF * DM;
    bf16* W13 = (bf16*)(A.ws + WS_W13 + (size_t)(l * 2 + i) * SZ_W13); bf16* W2 = (bf16*)(A.ws + WS_W2 + (size_t)(l * 2 + i) * SZ_W2);
    for (int it = gw; it < I_13; it += NGW) conv_item(w1, DM, DFF, W13, 1, scr, it, lane);
    for (int it = gw; it < I_13; it += NGW) conv_item(w3, DM, DFF, W13, 2, scr, it, lane);
    for (int it = gw; it < I_2; it += NGW) conv_item(w2, DFF, DM, W2, 0, scr, it, lane);
}
__device__ __forceinline__ void conv_inout(const Args& A, int l, LAS float* scr, int gw, int NGW, int lane) {
    constexpr int I_IN = (DM / 64) * (INC / 32), I_OUT = (DM / 64) * (DM / 32);
    bf16* WIN = (bf16*)(A.ws + WS_WIN + (size_t)l * SZ_WIN); bf16* WOUT = (bf16*)(A.ws + WS_WOUT + (size_t)l * SZ_WOUT);
    for (int it = gw; it < I_IN; it += NGW) conv_item(A.in[12] + (size_t)l * DM * INC, DM, INC, WIN, 0, scr, it, lane);
    for (int it = gw; it < I_OUT; it += NGW) conv_item(A.in[13] + (size_t)l * DM * DM, DM, DM, WOUT, 0, scr, it, lane);
    for (int i = gw * 64 + lane; i < 128 * DM / 8; i += NGW * 64) ((GAS v4u*)(WIN + (size_t)INC * DM))[i] = (v4u){0u, 0u, 0u, 0u};
}
__device__ __forceinline__ void conv_set(const Args& A, int set, LAS float* scr, int gw, int NGW, int lane) {
    if (set == 0) { for (int l = 0; l < 2; ++l) {
        bf16* LW = (bf16*)(A.ws + WS_LW + (size_t)l * MiB);
        for (int it = gw; it < 144; it += NGW) {
            if (it < 48) conv_item(A.in[19] + ((size_t)l * 2 + it / 24) * 64 * BWD, 64, BWD, LW + (size_t)(it / 24) * BWD * 64, 0, scr, it % 24, lane);
            else if (it < 96) conv_item(A.in[21] + ((size_t)l * 2 + (it - 48) / 24) * 64 * BWD, 64, BWD, LW + (size_t)(2 + (it - 48) / 24) * BWD * 64, 0, scr, (it - 48) % 24, lane);
            else conv_item(A.in[22] + (size_t)l * 128 * BWD, 128, BWD, LW + (size_t)4 * BWD * 64, 0, scr, it - 96, lane);
        }
        conv_ffn(A, l, 0, scr, gw, NGW, lane); conv_ffn(A, l, 1, scr, gw, NGW, lane); conv_inout(A, l, scr, gw, NGW, lane); } }
}

__device__ __forceinline__ void phase_prologue(const Args& A, LAS unsigned char* lds, int tid, int lane, int wave, int vcu, int G) {
    unsigned char* ws = A.ws;
    conv_set(A, 0, (LAS float*)(lds + wave * 8448), vcu * NWAVES + wave, G * NWAVES, lane);
    {
        const f32x4* xp = (const f32x4*)A.in[0]; const f32x4* xs = (const f32x4*)A.in[1]; f32x4* xo = (f32x4*)A.out;
        constexpr int NP = 4096 * DM / 4, NALL = NTOK * DM / 4;
        for (int i = vcu * 512 + tid; i < NALL; i += G * 512) xo[i] = i < NP ? xp[i] : xs[i - NP];
    }
    WG_SYNC();
    {
        LAS float* sct = (LAS float*)(lds + 0);
        LAS float* red = (LAS float*)(lds + 32768);
        for (int i = tid; i < 3 * DM; i += 512) { const int cd = i / DM, k = i % DM; const float s = cd == 0 ? A.in[5][k] : A.in[4][(cd - 1) * DM + k]; sct[i] = silu_f(s); }
        WG_SYNC();
        float* MOD = (float*)(ws + WS_MOD);
        for (int item = vcu; item < 2 * (NMODC / 64); item += G) {
            const int l = item / (NMODC / 64), j0 = (item % (NMODC / 64)) * 64;
            const float* w = A.in[7] + (size_t)l * DM * NMODC + j0 + lane;
            float a0 = 0.f, a1 = 0.f, a2 = 0.f;
#pragma unroll 8
            for (int k = wave * 256; k < wave * 256 + 256; ++k) { const float wv = w[(size_t)k * NMODC]; a0 += sct[k] * wv; a1 += sct[DM + k] * wv; a2 += sct[2 * DM + k] * wv; }
            red[(wave * 3 + 0) * 64 + lane] = a0; red[(wave * 3 + 1) * 64 + lane] = a1; red[(wave * 3 + 2) * 64 + lane] = a2;
            WG_SYNC();
            if (tid < 192) { const int cd = tid >> 6; float s = A.in[8][(size_t)l * NMODC + j0 + lane];
#pragma unroll
                for (int w8 = 0; w8 < 8; ++w8) s += red[(w8 * 3 + cd) * 64 + lane];
                MOD[(size_t)(l * 3 + cd) * NMODC + j0 + lane] = s; }
            WG_SYNC();
        }
    }
}

__device__ __forceinline__ void phase_norm(const float* x, const float* g, const float* mod, int sh_idx, bf16* H, float* xout, int lane, int wave, int vcu, int G) {
    const int gw = vcu * NWAVES + wave, NGW = G * NWAVES;
    for (int m = gw; m < NTOK; m += NGW) {
        const GAS f32x4* xr = (const GAS f32x4*)(x + (size_t)m * DM) + lane;
        f32x4 v[8]; float ss = 0.f;
#pragma unroll
        for (int j = 0; j < 8; ++j) { v[j] = xr[64 * j]; ss += (v[j].x * v[j].x + v[j].y * v[j].y) + (v[j].z * v[j].z + v[j].w * v[j].w); }
        const float rstd = rsqrtf(wave_sum(ss) * (1.f / DM) + 1e-6f);
        if (mod) {
            const int cond = m < 4096 ? 0 : 1 + ((m - 4096) >> 10);
            const float* sh = mod + (size_t)cond * NMODC + sh_idx * DM; const float* sc = sh + DM;
            GAS unsigned long long* o8 = (GAS unsigned long long*)(H + (size_t)m * DM) + lane;
#pragma unroll
            for (int j = 0; j < 8; ++j) { const int col = 4 * (lane + 64 * j);
                const f32x4 g4 = *(const f32x4*)(g + col), sc4 = *(const f32x4*)(sc + col), sh4 = *(const f32x4*)(sh + col);
                const f32x4 o = v[j] * rstd * g4 * (sc4 + 1.f) + sh4;
                o8[64 * j] = (unsigned long long)pk2(o.x, o.y) | ((unsigned long long)pk2(o.z, o.w) << 32); }
        } else {
            GAS f32x4* xo = (GAS f32x4*)(xout + (size_t)m * DM) + lane;
#pragma unroll
            for (int j = 0; j < 8; ++j) { const int col = 4 * (lane + 64 * j); const f32x4 g4 = *(const f32x4*)(g + col); xo[64 * j] = v[j] * rstd * g4; }
        }
    }
}

__device__ __forceinline__ void st_bf16(bf16* p, float v) { *p = (bf16)f2bf(v); }

typedef float f32x16a __attribute__((ext_vector_type(16)));
__device__ __forceinline__ unsigned cm_cvt_pk(float lo, float hi) { unsigned r; asm("v_cvt_pk_bf16_f32 %0, %1, %2" : "=v"(r) : "v"(lo), "v"(hi)); return r; }
__device__ __forceinline__ void chunk_mlp_item(const float* z, const float* ng, const float* wsp, const float* bs, bf16* o, LAS unsigned char* lds, int item, int tid, int lane, int wave) {
    constexpr int VROW = 272;
    const int chunk = item >> 2, g = item & 3, tok0 = chunk * 128;
    const float ng0 = ng[g * 128 + lane], ng1 = ng[g * 128 + lane + 64];
    {
        float za[8][4];
#pragma unroll
        for (int i = 0; i < 8; ++i) { const float* zr = z + (size_t)(tok0 + 2 * wave + 16 * i) * ZLD + 512 + g * 128; za[i][0] = zr[lane]; za[i][1] = zr[lane + 64]; za[i][2] = zr[ZLD + lane]; za[i][3] = zr[ZLD + lane + 64]; }
#pragma unroll
        for (int i = 0; i < 8; ++i) {
            const int q = 2 * wave + 16 * i;
            const float a0 = gelu_tanh(za[i][0]), b0 = gelu_tanh(za[i][1]), a1 = gelu_tanh(za[i][2]), b1 = gelu_tanh(za[i][3]);
            const float rs0 = rsqrtf(wave_sum(a0 * a0 + b0 * b0) * (1.f / 128.f) + 1e-6f), rs1 = rsqrtf(wave_sum(a1 * a1 + b1 * b1) * (1.f / 128.f) + 1e-6f);
            *(LAS unsigned*)(lds + lane * VROW + q * 2) = pk2(a0 * rs0 * ng0, a1 * rs1 * ng0);
            *(LAS unsigned*)(lds + (lane + 64) * VROW + q * 2) = pk2(b0 * rs0 * ng1, b1 * rs1 * ng1);
        }
    }
    WG_SYNC();
    const int fr = lane & 15, fq = lane >> 4;
    f32x4 acc[8];
#pragma unroll
    for (int ct = 0; ct < 8; ++ct) acc[ct] = (f32x4){0.f, 0.f, 0.f, 0.f};
    const float* wrow = wsp + ((size_t)g * 128 + 16 * wave + fr) * 128 + 8 * fq;
    f32x4 wa[8];
#pragma unroll
    for (int ks = 0; ks < 4; ++ks) { wa[2 * ks] = *(const f32x4*)(wrow + 32 * ks); wa[2 * ks + 1] = *(const f32x4*)(wrow + 32 * ks + 4); }
#pragma unroll
    for (int ks = 0; ks < 4; ++ks) {
        v4u aw; aw.x = pk2(wa[2 * ks].x, wa[2 * ks].y); aw.y = pk2(wa[2 * ks].z, wa[2 * ks].w); aw.z = pk2(wa[2 * ks + 1].x, wa[2 * ks + 1].y); aw.w = pk2(wa[2 * ks + 1].z, wa[2 * ks + 1].w);
        const bf16x8 af = __builtin_bit_cast(bf16x8, aw);
#pragma unroll
        for (int ct = 0; ct < 8; ++ct) {
            const bf16x8 bfr = *(const LAS bf16x8*)(lds + (16 * ct + fr) * VROW + (32 * ks + 8 * fq) * 2);
            acc[ct] = __builtin_amdgcn_mfma_f32_16x16x32_bf16(af, bfr, acc[ct], 0, 0, 0);
        }
    }
#pragma unroll
    for (int r = 0; r < 4; ++r) {
        const int p = 16 * wave + 4 * fq + r; const float bias = bs[g * 128 + p];
        const float* zu = z + (size_t)(tok0 + p) * ZLD + g * 128; bf16* op = o + (size_t)(tok0 + p) * DM + g * 128;
#pragma unroll
        for (int ct = 0; ct < 8; ++ct) { const int c = 16 * ct + fr; st_bf16(op + c, gelu_tanh(zu[c]) * (acc[ct][r] + bias)); }
    }
    WG_SYNC();
}

struct RwkvW { const float *mu, *w0, *w2, *a0, *a2, *g2, *kkw, *kaw, *rk; };
__device__ __forceinline__ void rwkv_prep_item(const float* z, const RwkvW P, unsigned char* ws, LAS unsigned char* lds, int item, int tid, int lane) {
    LAS float* zm = (LAS float*)lds;
    LAS float* xl = (LAS float*)(lds + 73728);
    float* R = (float*)(ws + WS_R); float* V = (float*)(ws + WS_V); float* KK = (float*)(ws + WS_KK); float* GATE = (float*)(ws + WS_GATE);
    float* W = (float*)(ws + WS_W); float* KD = (float*)(ws + WS_KD); float* Bv = (float*)(ws + WS_BV); float* BON = (float*)(ws + WS_BON);
    const int tok0 = item * 8;
#pragma unroll 1
    for (int th = 0; th < 2; ++th) {
        float cur[4][6], prv[4][6], nxt[4][6];
#pragma unroll
        for (int t4i = 0; t4i < 4; ++t4i) {
            const int m = tok0 + th * 4 + t4i; int t, T;
            if (m < 4096) { t = m & 255; T = 256; } else { t = (m - 4096) & 1023; T = 1024; }
            const float* zc = z + (size_t)m * ZLD + ZB0;
            const bool hp = t > 0, hn = t < T - 1;
#pragma unroll
            for (int i = 0; i < 6; ++i) { const int c = tid + 512 * i; const bool ok = c < 2688;
                cur[t4i][i] = ok ? zc[c] : 0.f; prv[t4i][i] = (ok && hp) ? zc[c - ZLD] : 0.f; nxt[t4i][i] = (ok && hn) ? zc[c + ZLD] : 0.f; }
        }
#pragma unroll
        for (int t4i = 0; t4i < 4; ++t4i) {
            const int tt = th * 4 + t4i;
#pragma unroll
            for (int i = 0; i < 6; ++i) {
                const int c = tid + 512 * i;
                if (c < 2688) {
                    float v = cur[t4i][i] + (0.5f * (prv[t4i][i] + nxt[t4i][i]) - cur[t4i][i]) * P.mu[c];
                    if (c < 2304) zm[tt * 2304 + c] = v;
                    else { const int j = c - 2304; if (j < 128) v = tanhf(v); else if (j >= 256) v = sigmoid_f(v); xl[j * 8 + tt] = v; }
                }
            }
        }
    }
    WG_SYNC();
    const int t4 = (tid >> 8) * 4;
    int cb_ = tid & 255; asm volatile("" : "+v"(cb_));
    const int cb = cb_;
    const f32x4 z4 = (f32x4){0.f, 0.f, 0.f, 0.f};
    f32x4 accw[3][2], acca[3][2], accg[3];
#pragma unroll
    for (int j = 0; j < 3; ++j) { accw[j][0] = accw[j][1] = acca[j][0] = acca[j][1] = accg[j] = z4; }
    {
        float wA[24], aA[24];
#pragma unroll 1
        for (int rb = 0; rb < 16; ++rb) {
            const int r0 = rb * 4;
#pragma unroll
            for (int j = 0; j < 3; ++j)
#pragma unroll
                for (int d = 0; d < 2; ++d)
#pragma unroll
                    for (int rr = 0; rr < 4; ++rr) { const size_t o = ((size_t)d * 64 + r0 + rr) * BWD + cb + 256 * j; wA[(j * 2 + d) * 4 + rr] = P.w2[o]; aA[(j * 2 + d) * 4 + rr] = P.a2[o]; }
#pragma unroll
            for (int d = 0; d < 2; ++d)
#pragma unroll
                for (int rr = 0; rr < 4; ++rr) {
                    const f32x4 xw = *(const LAS f32x4*)(xl + (d * 64 + r0 + rr) * 8 + t4), xa = *(const LAS f32x4*)(xl + (128 + d * 64 + r0 + rr) * 8 + t4);
#pragma unroll
                    for (int j = 0; j < 3; ++j) { accw[j][d] += xw * wA[(j * 2 + d) * 4 + rr]; acca[j][d] += xa * aA[(j * 2 + d) * 4 + rr]; }
                }
        }
    }
    {
        float gA[24];
#pragma unroll 1
        for (int rb = 0; rb < 16; ++rb) {
            const int r0 = rb * 8;
#pragma unroll
            for (int j = 0; j < 3; ++j)
#pragma unroll
                for (int rr = 0; rr < 8; ++rr) gA[j * 8 + rr] = P.g2[(size_t)(r0 + rr) * BWD + cb + 256 * j];
#pragma unroll
            for (int rr = 0; rr < 8; ++rr) { const f32x4 xg = *(const LAS f32x4*)(xl + (256 + r0 + rr) * 8 + t4);
#pragma unroll
                for (int j = 0; j < 3; ++j) accg[j] += xg * gA[j * 8 + rr]; }
        }
    }
#pragma unroll
    for (int j = 0; j < 3; ++j) {
        const int c = cb + 256 * j, head = c >> 6;
        const float w0v[2] = {P.w0[c], P.w0[BWD + c]}, a0v[2] = {P.a0[c], P.a0[BWD + c]}; const float kkwv = P.kkw[c], kawv = P.kaw[c], rkv = P.rk[c];
#pragma unroll
        for (int tt = 0; tt < 4; ++tt) {
            const int m = tok0 + t4 + tt;
            const float r_ = zm[(t4 + tt) * 2304 + c], k_ = zm[(t4 + tt) * 2304 + 768 + c], v_ = zm[(t4 + tt) * 2304 + 1536 + c];
            float kkv = k_ * kkwv;
            const float nrm = sqrtf(wave_sum(kkv * kkv));
            kkv = kkv / fmaxf(nrm, 1e-12f);
            float bon = 0.f;
#pragma unroll
            for (int d = 0; d < 2; ++d) {
                const float wraw = w0v[d] + accw[j][d][tt];
                const float dec = __expf(-0.6065306597126334f * sigmoid_f(wraw));
                const float a = sigmoid_f(a0v[d] + acca[j][d][tt]);
                const float kd = k_ * (1.f + (a - 1.f) * kawv);
                const size_t o = ((size_t)d * NTOK + m) * BWD + c;
                W[o] = dec; KD[o] = kd; Bv[o] = kkv * a;
                bon += r_ * kd * rkv;
            }
            bon = wave_sum(bon);
            if (lane == 0) BON[m * 12 + head] = bon;
            const size_t o = (size_t)m * BWD + c;
            R[o] = r_; V[o] = v_; KK[o] = kkv; GATE[o] = accg[j][tt];
        }
    }
    WG_SYNC();
}

__device__ __forceinline__ void hgrn_prep_row(const float* z, const float* hlb, int l, unsigned char* ws, int m, int tid) {
    float* QS = (float*)(ws + WS_QS); float* FG = (float*)(ws + WS_FG);
    const float* zr = z + (size_t)m * ZLD + ZC0;
    for (int c = tid; c < 768; c += 512) {
        QS[(size_t)m * 768 + c] = silu_f(zr[c]);
#pragma unroll
        for (int d = 0; d < 2; ++d) {
            float lbv = 0.f;
            if (l == 1) { const float h0 = hlb[d * 768 + c], h1 = hlb[(2 + d) * 768 + c]; lbv = 1.f / (1.f + __expf(h0 - h1)); }
            FG[((size_t)d * NTOK + m) * 768 + c] = lbv + (1.f - lbv) * sigmoid_f(zr[768 + d * 768 + c]);
        }
    }
}

__device__ __forceinline__ void rwkv_scan_chain(unsigned char* ws, const float* state_in, float* state_out, int l, int chain, int lane) {
    const float* R = (const float*)(ws + WS_R); const float* V = (const float*)(ws + WS_V); const float* KK = (const float*)(ws + WS_KK);
    const float* W = (const float*)(ws + WS_W); const float* KD = (const float*)(ws + WS_KD); const float* Bv = (const float*)(ws + WS_BV); float* Y = (float*)(ws + WS_Y);
    const int dir = chain & 1, head = (chain >> 1) % 12, seq = chain / 24;
    int T, base; float s[64];
    if (seq < 16) {
        T = 256; base = seq * 256;
#pragma unroll
        for (int k = 0; k < 64; ++k) s[k] = 0.f;
    } else {
        const int b = seq - 16; T = 1024; base = 4096 + b * 1024;
        const float* sp = state_in + ((((size_t)(b * 2 + l) * 2 + dir) * 12 + head) * 64 + lane) * 64;
#pragma unroll
        for (int k = 0; k < 64; ++k) s[k] = sp[k];
    }
    for (int step = 0; step < T; ++step) {
        const int t = dir ? T - 1 - step : step, m = base + t;
        const float* rp = R + (size_t)m * BWD + head * 64;
        const float* kkp = KK + (size_t)m * BWD + head * 64;
        const float* wp = W + ((size_t)dir * NTOK + m) * BWD + head * 64;
        const float* kdp = KD + ((size_t)dir * NTOK + m) * BWD + head * 64;
        const float* bp = Bv + ((size_t)dir * NTOK + m) * BWD + head * 64;
        const float vv = V[(size_t)m * BWD + head * 64 + lane];
        float sa = 0.f;
#pragma unroll
        for (int k = 0; k < 64; ++k) sa -= s[k] * kkp[k];
#pragma unroll
        for (int k = 0; k < 64; ++k) s[k] = s[k] * wp[k] + sa * bp[k] + vv * kdp[k];
        float y = 0.f;
#pragma unroll
        for (int k = 0; k < 64; ++k) y += s[k] * rp[k];
        Y[((size_t)dir * NTOK + m) * BWD + head * 64 + lane] = y;
    }
    if (seq < 16) {
        float* sp = state_out + ((((size_t)(seq * 2 + l) * 2 + dir) * 12 + head) * 64 + lane) * 64;
#pragma unroll
        for (int k = 0; k < 64; ++k) sp[k] = s[k];
    }
}
__device__ __forceinline__ void hgrn_scan_half(const float* z, unsigned char* ws, const float* state_in, float* state_out, int l, int item, int lane) {
    const float* QS = (const float*)(ws + WS_QS); const float* FG = (const float*)(ws + WS_FG); float* HO = (float*)(ws + WS_HO);
    const int chain = item >> 1, vcol = (item & 1) * 64 + lane;
    const int dir = chain & 1, head = (chain >> 1) % 6, seq = chain / 12;
    int T, base; float s[128];
    if (seq < 16) {
        T = 256; base = seq * 256;
#pragma unroll
        for (int k = 0; k < 128; ++k) s[k] = 0.f;
    } else {
        const int b = seq - 16; T = 1024; base = 4096 + b * 1024;
        const float* sp = state_in + (((size_t)(b * 2 + l) * 2 + dir) * 6 + head) * 128 * 128 + vcol;
#pragma unroll
        for (int k = 0; k < 128; ++k) s[k] = sp[k * 128];
    }
    for (int step = 0; step < T; ++step) {
        const int t = dir ? T - 1 - step : step, m = base + t;
        const float* qp = QS + (size_t)m * 768 + head * 128;
        const float* fp = FG + ((size_t)dir * NTOK + m) * 768 + head * 128;
        const float vv = z[(size_t)m * ZLD + ZC0 + 2304 + head * 128 + vcol];
        float o = 0.f;
#pragma unroll
        for (int k = 0; k < 128; ++k) { const float f = fp[k]; s[k] = f * s[k] + (1.f - f) * vv; o += s[k] * qp[k]; }
        HO[((size_t)dir * NTOK + m) * 768 + head * 128 + vcol] = o;
    }
    if (seq < 16) {
        float* sp = state_out + (((size_t)(seq * 2 + l) * 2 + dir) * 6 + head) * 128 * 128 + vcol;
#pragma unroll
        for (int k = 0; k < 128; ++k) sp[k * 128] = s[k];
    }
}

__device__ __forceinline__ void rwkv_post_item4(unsigned char* ws, const float* lg, const float* lb, bf16* o, int j, int lane) {
    const float* Y = (const float*)(ws + WS_Y); const float* V = (const float*)(ws + WS_V); const float* GATE = (const float*)(ws + WS_GATE); const float* BON = (const float*)(ws + WS_BON);
    const int m = j / 3, h0 = (j - 3 * m) * 4;
    float y[4], v[4], g[4], bo[4], lgv[4], lbv[4];
#pragma unroll
    for (int q = 0; q < 4; ++q) { const int c = (h0 + q) * 64 + lane; const size_t i = (size_t)m * BWD + c;
        y[q] = Y[i] + Y[(size_t)NTOK * BWD + i]; v[q] = V[i]; g[q] = GATE[i]; bo[q] = BON[m * 12 + h0 + q]; lgv[q] = lg[c]; lbv[q] = lb[c]; }
#pragma unroll
    for (int q = 0; q < 4; ++q) {
        const float mean = wave_sum(y[q]) * (1.f / 64.f);
        const float dv = y[q] - mean;
        const float var = wave_sum(dv * dv) * (1.f / 64.f);
        const float out = dv * rsqrtf(var + 64e-5f) * lgv[q] + lbv[q] + bo[q] * v[q];
        st_bf16(o + (size_t)m * DM + 512 + (h0 + q) * 64 + lane, out * g[q]);
    }
}
__device__ __forceinline__ void hgrn_post_item2(const float* z, unsigned char* ws, const float* gn, bf16* o, int j, int lane) {
    const float* HO = (const float*)(ws + WS_HO);
    const int m = j / 3, h0 = (j - 3 * m) * 2;
    float v0[2], v1[2], g0[2], g1[2];
#pragma unroll
    for (int q = 0; q < 2; ++q) { const size_t i = (size_t)m * 768 + (h0 + q) * 128 + lane; const float* gp = z + (size_t)m * ZLD + ZC0 + 3072 + (h0 + q) * 128;
        v0[q] = HO[i] + HO[(size_t)NTOK * 768 + i]; v1[q] = HO[i + 64] + HO[(size_t)NTOK * 768 + i + 64]; g0[q] = gp[lane]; g1[q] = gp[lane + 64]; }
    const float gn0 = gn[lane], gn1 = gn[lane + 64];
#pragma unroll
    for (int q = 0; q < 2; ++q) {
        const float rstd = rsqrtf(wave_sum(v0[q] * v0[q] + v1[q] * v1[q]) * (1.f / 128.f) + 1e-6f);
        st_bf16(o + (size_t)m * DM + 1280 + (h0 + q) * 128 + lane, v0[q] * rstd * gn0 * silu_f(g0[q]));
        st_bf16(o + (size_t)m * DM + 1280 + (h0 + q) * 128 + lane + 64, v1[q] * rstd * gn1 * silu_f(g1[q]));
    }
}

#define RW_QP(i) " quad_perm:[" #i "," #i "," #i "," #i "] row_mask:0xf bank_mask:0xf bound_ctrl:1"
typedef float f32x2 __attribute__((ext_vector_type(2)));
__device__ __forceinline__ void rw_sa_block(float& sa0, float& sa1, float av, float s0, float s1, float s2, float s3) {
    asm("v_fmac_f32_dpp %0, %2, %3" RW_QP(0) "\n\t"
        "v_fmac_f32_dpp %1, %2, %4" RW_QP(1) "\n\t"
        "v_fmac_f32_dpp %0, %2, %5" RW_QP(2) "\n\t"
        "v_fmac_f32_dpp %1, %2, %6" RW_QP(3)
        : "+v"(sa0), "+v"(sa1) : "v"(av), "v"(s0), "v"(s1), "v"(s2), "v"(s3));
}
__device__ __forceinline__ void rw_upd_block(float& s0, float& s1, float& s2, float& s3, float& y0, float& y1, float wv, float bv, float kdv, float rv, float sa, float vv) {
    asm("v_mul_f32_dpp %0, %6, %0" RW_QP(0) "\n\t"
        "v_mul_f32_dpp %1, %6, %1" RW_QP(1) "\n\t"
        "v_mul_f32_dpp %2, %6, %2" RW_QP(2) "\n\t"
        "v_mul_f32_dpp %3, %6, %3" RW_QP(3) "\n\t"
        "v_fmac_f32_dpp %0, %7, %10" RW_QP(0) "\n\t"
        "v_fmac_f32_dpp %1, %7, %10" RW_QP(1) "\n\t"
        "v_fmac_f32_dpp %2, %7, %10" RW_QP(2) "\n\t"
        "v_fmac_f32_dpp %3, %7, %10" RW_QP(3) "\n\t"
        "v_fmac_f32_dpp %0, %8, %11" RW_QP(0) "\n\t"
        "v_fmac_f32_dpp %1, %8, %11" RW_QP(1) "\n\t"
        "v_fmac_f32_dpp %2, %8, %11" RW_QP(2) "\n\t"
        "v_fmac_f32_dpp %3, %8, %11" RW_QP(3) "\n\t"
        "v_fmac_f32_dpp %4, %9, %0" RW_QP(0) "\n\t"
        "v_fmac_f32_dpp %5, %9, %1" RW_QP(1) "\n\t"
        "v_fmac_f32_dpp %4, %9, %2" RW_QP(2) "\n\t"
        "v_fmac_f32_dpp %5, %9, %3" RW_QP(3)
        : "+v"(s0), "+v"(s1), "+v"(s2), "+v"(s3), "+v"(y0), "+v"(y1) : "v"(wv), "v"(bv), "v"(kdv), "v"(rv), "v"(sa), "v"(vv));
}
__device__ __forceinline__ float rw_xsum32(float x) { const unsigned u = __builtin_bit_cast(unsigned, x); auto r = __builtin_amdgcn_permlane32_swap(u, u, false, false); return __builtin_bit_cast(float, (unsigned)r[0]) + __builtin_bit_cast(float, (unsigned)r[1]); }
__device__ __forceinline__ float rw_xsum16(float x) { const unsigned u = __builtin_bit_cast(unsigned, x); auto r = __builtin_amdgcn_permlane16_swap(u, u, false, false); return __builtin_bit_cast(float, (unsigned)r[0]) + __builtin_bit_cast(float, (unsigned)r[1]); }
__device__ __forceinline__ float rw_xsum8(float x) { return x + __builtin_bit_cast(float, __builtin_amdgcn_update_dpp(0, __builtin_bit_cast(int, x), 0x128  , 0xf, 0xf, false)); }
__device__ __forceinline__ float rw_xsum4(float x) { return x + __builtin_bit_cast(float, __builtin_amdgcn_update_dpp(0, __builtin_bit_cast(int, x), 0x124  , 0xf, 0xf, false)); }
template <int KS> __device__ __forceinline__ float rw_kseg_sum(float x) {
    if (KS >= 8) x = rw_xsum8(x);
    if (KS >= 16) x = rw_xsum4(x);
    if (KS >= 4) x = rw_xsum16(x);
    if (KS >= 2) x = rw_xsum32(x);
    return x;
}

template <int NM> __device__ __forceinline__ void rw_ldv(float (&d)[NM], const LAS unsigned char* p) {
    if constexpr (NM == 1) { d[0] = *(const LAS float*)p; }
    else if constexpr (NM == 2) { const f32x2 v = *(const LAS f32x2*)p; d[0] = v.x; d[1] = v.y; }
    else {
#pragma unroll
        for (int m = 0; m < NM; m += 4) { const f32x4 v = *(const LAS f32x4*)(p + m * 4); d[m] = v.x; d[m + 1] = v.y; d[m + 2] = v.z; d[m + 3] = v.w; }
    }
}
template <int KS>
__device__ __forceinline__ void rwkv_scan_wave(unsigned char* ws, const float* state_in, float* state_out, int l, int chain, int rowblk, LAS unsigned char* wlds, int lane) {
    constexpr int RW = 64 / KS, KL = 64 / KS, NM = KL / 4, TS = 4;
    constexpr int TILE_BYTES = 6 * TS * 256;
    const int rowbase = rowblk * RW;
    const int j = lane & 3, q = lane >> 2, rq = q % (RW / 4), kseg = q / (RW / 4), row = rowbase + 4 * rq + j;
    const int dir = chain & 1, head = (chain >> 1) % 12, seq = chain / 24;
    const int T = seq < 16 ? 256 : 1024, base = seq < 16 ? seq * 256 : 4096 + (seq - 16) * 1024;
    float* Y = (float*)(ws + WS_Y);
    float s[KL];
    if (seq < 16) {
#pragma unroll
        for (int k = 0; k < KL; ++k) s[k] = 0.f;
    } else {
        const float* sp = state_in + (((((size_t)(seq - 16) * 2 + l) * 2 + dir) * 12 + head) * 64 + row) * 64 + kseg * KL;
#pragma unroll
        for (int k = 0; k < KL; k += 4) { const f32x4 v = *(const f32x4*)(sp + k); s[k] = v.x; s[k + 1] = v.y; s[k + 2] = v.z; s[k + 3] = v.w; }
    }
    const int ntiles = T / TS;
    const int tstep = dir ? -TS * BWD * 4 : TS * BWD * 4;
    long voff;
    { const int st = lane >> 4, tok0 = dir ? T - 1 - st : st; voff = ((long)(base + tok0) * BWD + head * 64) * 4 + (lane & 15) * 16; }
    const size_t abase[6] = {WS_W + (size_t)dir * SZ_T, WS_KD + (size_t)dir * SZ_T, WS_BV + (size_t)dir * SZ_T, WS_KK, WS_R, WS_V};
#define RW_ISSUE(ti, bufoff) do { _Pragma("unroll") for (int _a = 0; _a < 6; ++_a) \
        __builtin_amdgcn_global_load_lds((const unsigned*)((const char*)ws + abase[_a] + voff + (long)(ti) * tstep), (LAS unsigned*)(wlds + (bufoff) + _a * TS * 256), 16, 0, 0); } while (0)
    RW_ISSUE(0, 0);
    const unsigned opoff = (unsigned)((kseg * KL + j * NM) * 4), voffv = (unsigned)(5 * TS * 256 + row * 4);
    float ybuf[TS];
    for (int ti = 0; ti < ntiles; ++ti) {
        asm volatile("s_waitcnt vmcnt(0) lgkmcnt(0)" ::: "memory");
        if (ti + 1 < ntiles) RW_ISSUE(ti + 1, ((ti + 1) & 1) * TILE_BYTES);
        if (ti > 0 && kseg == 0) {
#pragma unroll
            for (int st = 0; st < TS; ++st) { const int sg = (ti - 1) * TS + st, t = dir ? T - 1 - sg : sg; Y[((size_t)dir * NTOK + base + t) * BWD + head * 64 + row] = ybuf[st]; }
        }
        const LAS unsigned char* tb = wlds + (ti & 1) * TILE_BYTES;
        float wv[2][NM], kdv[2][NM], bv[2][NM], kkv[2][NM], rv[2][NM], vv[2];
#define RW_LOADOPS(bi, st_) do { rw_ldv<NM>(wv[bi], tb + opoff + (0 * TS + (st_)) * 256); rw_ldv<NM>(kdv[bi], tb + opoff + (1 * TS + (st_)) * 256); rw_ldv<NM>(bv[bi], tb + opoff + (2 * TS + (st_)) * 256); \
            rw_ldv<NM>(kkv[bi], tb + opoff + (3 * TS + (st_)) * 256); rw_ldv<NM>(rv[bi], tb + opoff + (4 * TS + (st_)) * 256); vv[bi] = *(const LAS float*)(tb + voffv + (st_) * 256); } while (0)
        RW_LOADOPS(0, 0);
#pragma unroll
        for (int st = 0; st < TS; ++st) {
            constexpr int dummy = 0; (void)dummy;
            const int cb = st & 1, nb = cb ^ 1;
            if (st + 1 < TS) RW_LOADOPS(nb, st + 1);
            __builtin_amdgcn_sched_barrier(0);
            float sa0 = 0.f, sa1 = 0.f;
#pragma unroll
            for (int m = 0; m < NM; ++m) rw_sa_block(sa0, sa1, kkv[cb][m], s[m], s[NM + m], s[2 * NM + m], s[3 * NM + m]);
            const float sa = -rw_kseg_sum<KS>(sa0 + sa1);
            float y0 = 0.f, y1 = 0.f;
#pragma unroll
            for (int m = 0; m < NM; ++m) rw_upd_block(s[m], s[NM + m], s[2 * NM + m], s[3 * NM + m], y0, y1, wv[cb][m], bv[cb][m], kdv[cb][m], rv[cb][m], sa, vv[cb]);
            ybuf[st] = y0 + y1;
        }
#undef RW_LOADOPS
        if (KS >= 8) {
#pragma unroll
            for (int st = 0; st < TS; ++st) ybuf[st] = rw_xsum8(ybuf[st]);
        }
        if (KS >= 16) {
#pragma unroll
            for (int st = 0; st < TS; ++st) ybuf[st] = rw_xsum4(ybuf[st]);
        }
        if (KS >= 4) {
#pragma unroll
            for (int st = 0; st < TS; ++st) ybuf[st] = rw_xsum16(ybuf[st]);
        }
#pragma unroll
        for (int st = 0; st < TS; ++st) ybuf[st] = rw_xsum32(ybuf[st]);
    }
    if (kseg == 0) {
#pragma unroll
        for (int st = 0; st < TS; ++st) { const int sg = (ntiles - 1) * TS + st, t = dir ? T - 1 - sg : sg; Y[((size_t)dir * NTOK + base + t) * BWD + head * 64 + row] = ybuf[st]; }
    }
#undef RW_ISSUE
    if (seq < 16) {
        float* sp = state_out + (((((size_t)seq * 2 + l) * 2 + dir) * 12 + head) * 64 + row) * 64 + kseg * KL;
#pragma unroll
        for (int k = 0; k < KL; k += 4) *(f32x4*)(sp + k) = (f32x4){s[k], s[k + 1], s[k + 2], s[k + 3]};
    }
    asm volatile("s_waitcnt vmcnt(0) lgkmcnt(0)" ::: "memory");
}

#define RQ_P0 " quad_perm:[0,0,2,2] row_mask:0xf bank_mask:0xf bound_ctrl:1"
#define RQ_P1 " quad_perm:[1,1,3,3] row_mask:0xf bank_mask:0xf bound_ctrl:1"
__device__ __forceinline__ void rq_sa_all(float& a0, float& a1, float& a2, float& a3, const float (&kk)[4], const float (&s)[8]) {
    asm("v_fmac_f32_dpp %0, %4, %8" RQ_P0 "\n\t" "v_fmac_f32_dpp %1, %5, %9" RQ_P0 "\n\t" "v_fmac_f32_dpp %2, %6, %10" RQ_P0 "\n\t" "v_fmac_f32_dpp %3, %7, %11" RQ_P0 "\n\t"
        "v_fmac_f32_dpp %0, %4, %12" RQ_P1 "\n\t" "v_fmac_f32_dpp %1, %5, %13" RQ_P1 "\n\t" "v_fmac_f32_dpp %2, %6, %14" RQ_P1 "\n\t" "v_fmac_f32_dpp %3, %7, %15" RQ_P1
        : "+v"(a0), "+v"(a1), "+v"(a2), "+v"(a3) : "v"(kk[0]), "v"(kk[1]), "v"(kk[2]), "v"(kk[3]), "v"(s[0]), "v"(s[1]), "v"(s[2]), "v"(s[3]), "v"(s[4]), "v"(s[5]), "v"(s[6]), "v"(s[7]));
}
__device__ __forceinline__ void rq_upd_all(float (&s)[8], float& y0, float& y1, const float (&w)[4], const float (&b)[4], const float (&kd)[4], const float (&r)[4], float sa, float vv) {
    asm("v_mul_f32_dpp %0, %10, %0" RQ_P0 "\n\t" "v_mul_f32_dpp %1, %11, %1" RQ_P0 "\n\t" "v_mul_f32_dpp %2, %12, %2" RQ_P0 "\n\t" "v_mul_f32_dpp %3, %13, %3" RQ_P0 "\n\t"
        "v_mul_f32_dpp %4, %10, %4" RQ_P1 "\n\t" "v_mul_f32_dpp %5, %11, %5" RQ_P1 "\n\t" "v_mul_f32_dpp %6, %12, %6" RQ_P1 "\n\t" "v_mul_f32_dpp %7, %13, %7" RQ_P1 "\n\t"
        "v_fmac_f32_dpp %0, %14, %26" RQ_P0 "\n\t" "v_fmac_f32_dpp %1, %15, %26" RQ_P0 "\n\t" "v_fmac_f32_dpp %2, %16, %26" RQ_P0 "\n\t" "v_fmac_f32_dpp %3, %17, %26" RQ_P0 "\n\t"
        "v_fmac_f32_dpp %4, %14, %26" RQ_P1 "\n\t" "v_fmac_f32_dpp %5, %15, %26" RQ_P1 "\n\t" "v_fmac_f32_dpp %6, %16, %26" RQ_P1 "\n\t" "v_fmac_f32_dpp %7, %17, %26" RQ_P1 "\n\t"
        "v_fmac_f32_dpp %0, %18, %27" RQ_P0 "\n\t" "v_fmac_f32_dpp %1, %19, %27" RQ_P0 "\n\t" "v_fmac_f32_dpp %2, %20, %27" RQ_P0 "\n\t" "v_fmac_f32_dpp %3, %21, %27" RQ_P0 "\n\t"
        "v_fmac_f32_dpp %4, %18, %27" RQ_P1 "\n\t" "v_fmac_f32_dpp %5, %19, %27" RQ_P1 "\n\t" "v_fmac_f32_dpp %6, %20, %27" RQ_P1 "\n\t" "v_fmac_f32_dpp %7, %21, %27" RQ_P1 "\n\t"
        "v_fmac_f32_dpp %8, %22, %0" RQ_P0 "\n\t" "v_fmac_f32_dpp %9, %23, %1" RQ_P0 "\n\t" "v_fmac_f32_dpp %8, %24, %2" RQ_P0 "\n\t" "v_fmac_f32_dpp %9, %25, %3" RQ_P0 "\n\t"
        "v_fmac_f32_dpp %8, %22, %4" RQ_P1 "\n\t" "v_fmac_f32_dpp %9, %23, %5" RQ_P1 "\n\t" "v_fmac_f32_dpp %8, %24, %6" RQ_P1 "\n\t" "v_fmac_f32_dpp %9, %25, %7" RQ_P1
        : "+v"(s[0]), "+v"(s[1]), "+v"(s[2]), "+v"(s[3]), "+v"(s[4]), "+v"(s[5]), "+v"(s[6]), "+v"(s[7]), "+v"(y0), "+v"(y1)
        : "v"(w[0]), "v"(w[1]), "v"(w[2]), "v"(w[3]), "v"(b[0]), "v"(b[1]), "v"(b[2]), "v"(b[3]), "v"(kd[0]), "v"(kd[1]), "v"(kd[2]), "v"(kd[3]), "v"(r[0]), "v"(r[1]), "v"(r[2]), "v"(r[3]), "v"(sa), "v"(vv));
}
#define RQ_SWP " quad_perm:[2,3,0,1] row_mask:0xf bank_mask:0xf"
__device__ __forceinline__ float rq_sum(float x) {
    float r;
    asm("s_nop 1\n\tv_add_f32_dpp %0, %1, %1" RQ_SWP "\n\ts_nop 1\n\tv_add_f32_dpp %0, %0, %0 row_ror:8 row_mask:0xf bank_mask:0xf\n\ts_nop 1\n\tv_add_f32_dpp %0, %0, %0 row_ror:4 row_mask:0xf bank_mask:0xf"
        : "=&v"(r) : "v"(x));
    return r;
}
__device__ __forceinline__ void rq_sum4(float (&y)[4]) {
    asm("s_nop 1\n\t"
        "v_add_f32_dpp %0, %0, %0" RQ_SWP "\n\t" "v_add_f32_dpp %1, %1, %1" RQ_SWP "\n\t" "v_add_f32_dpp %2, %2, %2" RQ_SWP "\n\t" "v_add_f32_dpp %3, %3, %3" RQ_SWP "\n\t"
        "v_add_f32_dpp %0, %0, %0 row_ror:8 row_mask:0xf bank_mask:0xf\n\t" "v_add_f32_dpp %1, %1, %1 row_ror:8 row_mask:0xf bank_mask:0xf\n\t"
        "v_add_f32_dpp %2, %2, %2 row_ror:8 row_mask:0xf bank_mask:0xf\n\t" "v_add_f32_dpp %3, %3, %3 row_ror:8 row_mask:0xf bank_mask:0xf\n\t"
        "v_add_f32_dpp %0, %0, %0 row_ror:4 row_mask:0xf bank_mask:0xf\n\t" "v_add_f32_dpp %1, %1, %1 row_ror:4 row_mask:0xf bank_mask:0xf\n\t"
        "v_add_f32_dpp %2, %2, %2 row_ror:4 row_mask:0xf bank_mask:0xf\n\t" "v_add_f32_dpp %3, %3, %3 row_ror:4 row_mask:0xf bank_mask:0xf"
        : "+v"(y[0]), "+v"(y[1]), "+v"(y[2]), "+v"(y[3]));
}
__device__ __forceinline__ void rwkv_scan_wave_l8(unsigned char* ws, const float* state_in, float* state_out, int l, int chain, int rowblk, LAS unsigned char* wlds, int lane) {
    constexpr int KL = 8, TS = 4, TILE_BYTES = 6 * TS * 256;
    const int jr = lane & 1, kseg = ((lane >> 2) & 3) * 2 + ((lane >> 1) & 1), row = rowblk * 8 + 2 * (lane >> 4) + jr;
    const int dir = chain & 1, head = (chain >> 1) % 12, seq = chain / 24;
    const int T = seq < 16 ? 256 : 1024, base = seq < 16 ? seq * 256 : 4096 + (seq - 16) * 1024;
    float* Y = (float*)(ws + WS_Y);
    float s[KL];
    if (seq < 16) {
#pragma unroll
        for (int k = 0; k < KL; ++k) s[k] = 0.f;
    } else {
        const float* sp = state_in + (((((size_t)(seq - 16) * 2 + l) * 2 + dir) * 12 + head) * 64 + row) * 64 + kseg * KL;
        const f32x4 v0 = *(const f32x4*)sp, v1 = *(const f32x4*)(sp + 4);
        s[0] = v0.x; s[1] = v0.y; s[2] = v0.z; s[3] = v0.w; s[4] = v1.x; s[5] = v1.y; s[6] = v1.z; s[7] = v1.w;
    }
    const int ntiles = T / TS;
    const int tstep = dir ? -TS * BWD * 4 : TS * BWD * 4;
    long voff;
    { const int st = lane >> 4, tok0 = dir ? T - 1 - st : st; voff = ((long)(base + tok0) * BWD + head * 64) * 4 + (lane & 15) * 16; }
    const size_t abase[6] = {WS_W + (size_t)dir * SZ_T, WS_KD + (size_t)dir * SZ_T, WS_BV + (size_t)dir * SZ_T, WS_KK, WS_R, WS_V};
#define RQ_ISSUE(ti, bufoff) do { _Pragma("unroll") for (int _a = 0; _a < 6; ++_a) \
        __builtin_amdgcn_global_load_lds((const unsigned*)((const char*)ws + abase[_a] + voff + (long)(ti) * tstep), (LAS unsigned*)(wlds + (bufoff) + _a * TS * 256), 16, 0, 0); } while (0)
    RQ_ISSUE(0, 0);
    const unsigned opoff = (unsigned)((kseg * KL + jr * 4) * 4), voffv = (unsigned)(5 * TS * 256 + row * 4);
    const bool wr = (lane & 0xE) == 0;
    float ybuf[TS];
    for (int ti = 0; ti < ntiles; ++ti) {
        asm volatile("s_waitcnt vmcnt(0) lgkmcnt(0)" ::: "memory");
        if (ti + 1 < ntiles) RQ_ISSUE(ti + 1, ((ti + 1) & 1) * TILE_BYTES);
        if (ti > 0 && wr) {
#pragma unroll
            for (int st = 0; st < TS; ++st) { const int sg = (ti - 1) * TS + st, t = dir ? T - 1 - sg : sg; Y[((size_t)dir * NTOK + base + t) * BWD + head * 64 + row] = ybuf[st]; }
        }
        const LAS unsigned char* tb = wlds + (ti & 1) * TILE_BYTES;
        float wv[2][4], kdv[2][4], bv[2][4], kkv[2][4], rv[2][4], vv[2];
#define RQ_LOADOPS(bi, st_) do { rw_ldv<4>(wv[bi], tb + opoff + (0 * TS + (st_)) * 256); rw_ldv<4>(kdv[bi], tb + opoff + (1 * TS + (st_)) * 256); rw_ldv<4>(bv[bi], tb + opoff + (2 * TS + (st_)) * 256); \
            rw_ldv<4>(kkv[bi], tb + opoff + (3 * TS + (st_)) * 256); rw_ldv<4>(rv[bi], tb + opoff + (4 * TS + (st_)) * 256); vv[bi] = *(const LAS float*)(tb + voffv + (st_) * 256); } while (0)
        RQ_LOADOPS(0, 0);
#pragma unroll
        for (int st = 0; st < TS; ++st) {
            const int cb = st & 1, nb = cb ^ 1;
            if (st + 1 < TS) RQ_LOADOPS(nb, st + 1);
            __builtin_amdgcn_sched_barrier(0);
            float a0 = 0.f, a1 = 0.f, a2 = 0.f, a3 = 0.f;
            rq_sa_all(a0, a1, a2, a3, kkv[cb], s);
            const float sa = -rq_sum((a0 + a1) + (a2 + a3));
            float y0 = 0.f, y1 = 0.f;
            rq_upd_all(s, y0, y1, wv[cb], bv[cb], kdv[cb], rv[cb], sa, vv[cb]);
            ybuf[st] = y0 + y1;
        }
#undef RQ_LOADOPS
        rq_sum4(ybuf);
    }
#undef RQ_ISSUE
    if (wr) {
#pragma unroll
        for (int st = 0; st < TS; ++st) { const int sg = (ntiles - 1) * TS + st, t = dir ? T - 1 - sg : sg; Y[((size_t)dir * NTOK + base + t) * BWD + head * 64 + row] = ybuf[st]; }
    }
    if (seq < 16) {
        float* sp = state_out + (((((size_t)seq * 2 + l) * 2 + dir) * 12 + head) * 64 + row) * 64 + kseg * KL;
        *(f32x4*)sp = (f32x4){s[0], s[1], s[2], s[3]}; *(f32x4*)(sp + 4) = (f32x4){s[4], s[5], s[6], s[7]};
    }
    asm volatile("s_waitcnt vmcnt(0) lgkmcnt(0)" ::: "memory");
}
typedef float f32x16 __attribute__((ext_vector_type(16)));
constexpr int HG_BLK = 32768;
__device__ __forceinline__ int hg_tau(int s, int h, int jj) { return 16 * s + 8 * (jj >> 2) + 4 * h + (jj & 3); }

__device__ __forceinline__ void hgrn_prep_item(const float* z, const float* hlb, int l, unsigned char* ws, LAS unsigned char* lds, int item, int tid) {
    LAS float* QS = (LAS float*)lds;
    LAS float* FG = (LAS float*)(lds + 16384);
    LAS float* VV = (LAS float*)(lds + 49152);
    LAS bf16* QT = (LAS bf16*)(lds + 65536);
    LAS bf16* KT = (LAS bf16*)(lds + 81920);
    const int gc = item / 6, head = item % 6, t0 = gc * 32;
    {
        const int k = tid & 127, c = head * 128 + k, p0 = tid >> 7;
        float lbv[2] = {0.f, 0.f};
        if (l == 1) {
#pragma unroll
            for (int d = 0; d < 2; ++d) { const float h0 = hlb[d * 768 + c], h1 = hlb[(2 + d) * 768 + c]; lbv[d] = 1.f / (1.f + __expf(h0 - h1)); }
        }
        float zq[8], zv[8], zf0[8], zf1[8];
#pragma unroll
        for (int i = 0; i < 8; ++i) { const float* zr = z + (size_t)(t0 + p0 + 4 * i) * ZLD + ZC0 + c; zq[i] = zr[0]; zv[i] = zr[2304]; zf0[i] = zr[768]; zf1[i] = zr[1536]; }
#pragma unroll
        for (int i = 0; i < 8; ++i) { const int idx = tid + 512 * i;
            QS[idx] = silu_f(zq[i]); VV[idx] = zv[i];
            FG[idx] = lbv[0] + (1.f - lbv[0]) * sigmoid_f(zf0[i]); FG[4096 + idx] = lbv[1] + (1.f - lbv[1]) * sigmoid_f(zf1[i]); }
    }
    WG_SYNC();
    if (tid < 256) {
        const int k = tid & 127, d = tid >> 7; float b = 0.f;
        for (int p = 0; p < 32; ++p) {
            const int tok = d ? 31 - p : p; const float fg = FG[d * 4096 + tok * 128 + k];
            b += __logf(fg);
            QT[d * 4096 + p * 128 + k] = (bf16)f2bf(QS[tok * 128 + k] * __expf(b));
            KT[d * 4096 + p * 128 + k] = (bf16)f2bf((1.f - fg) * __expf(fminf(-b, 80.f)));
        }
        ((float*)(ws + WS_EB))[((size_t)item * 2 + d) * 128 + k] = __expf(b);
    }
    WG_SYNC();
    const int f = tid >> 6, ln = tid & 63, r = ln & 31, h = ln >> 5, kt = f >> 1, s = f & 1;
#pragma unroll
    for (int d = 0; d < 2; ++d) {
        unsigned char* blk = ws + WS_HF + ((size_t)item * 2 + d) * HG_BLK;
        {
            const int k0 = 32 * kt + 16 * s + 4 * h;
            const LAS unsigned long long* qa = (const LAS unsigned long long*)(QT + d * 4096 + r * 128 + k0);
            const LAS unsigned long long* ka = (const LAS unsigned long long*)(KT + d * 4096 + r * 128 + k0);
            typedef unsigned long long u64x2 __attribute__((ext_vector_type(2)));
            *(GAS u64x2*)(blk + f * 1024 + ln * 16) = (u64x2){qa[0], qa[2]};
            *(GAS u64x2*)(blk + 8192 + f * 1024 + ln * 16) = (u64x2){ka[0], ka[2]};
        }
        {
            unsigned w[4];
#pragma unroll
            for (int jp = 0; jp < 4; ++jp) { const unsigned lo = KT[d * 4096 + hg_tau(s, h, 2 * jp) * 128 + 32 * kt + r], hi = KT[d * 4096 + hg_tau(s, h, 2 * jp + 1) * 128 + 32 * kt + r]; w[jp] = lo | (hi << 16); }
            *(GAS v4u*)(blk + 16384 + f * 1024 + ln * 16) = (v4u){w[0], w[1], w[2], w[3]};
        }
        {
            unsigned w[4];
#pragma unroll
            for (int jp = 0; jp < 4; ++jp) { const int p0 = hg_tau(s, h, 2 * jp), p1 = hg_tau(s, h, 2 * jp + 1);
                const float a = VV[(d ? 31 - p0 : p0) * 128 + 32 * kt + r], b2 = VV[(d ? 31 - p1 : p1) * 128 + 32 * kt + r]; w[jp] = pk2(a, b2); }
            *(GAS v4u*)(blk + 24576 + f * 1024 + ln * 16) = (v4u){w[0], w[1], w[2], w[3]};
        }
    }
    WG_SYNC();
}

__device__ __forceinline__ unsigned hg_cvt_pk(float lo, float hi) { unsigned r; asm("v_cvt_pk_bf16_f32 %0, %1, %2" : "=v"(r) : "v"(lo), "v"(hi)); return r; }
__device__ __forceinline__ bf16x8 hg_pack8(const f32x16& x, int s8) {
    v4u w; w.x = hg_cvt_pk(x[s8 + 0], x[s8 + 1]); w.y = hg_cvt_pk(x[s8 + 2], x[s8 + 3]); w.z = hg_cvt_pk(x[s8 + 4], x[s8 + 5]); w.w = hg_cvt_pk(x[s8 + 6], x[s8 + 7]);
    return __builtin_bit_cast(bf16x8, w);
}
__device__ __forceinline__ void hgrn_scan_wave(unsigned char* ws, const float* state_in, float* state_out, int l, int chain, int vs, int lane) {
    const int dir = chain & 1, head = (chain >> 1) % 6, seq = chain / 12;
    const int T = seq < 16 ? 256 : 1024, base = seq < 16 ? seq * 256 : 4096 + (seq - 16) * 1024, NC = T / 32, gc0 = base / 32;
    const int c = lane & 31, h = lane >> 5;
    float* HO = (float*)(ws + WS_HO);
    f32x16 S[4];
    if (seq < 16) {
#pragma unroll
        for (int kt = 0; kt < 4; ++kt)
#pragma unroll
            for (int r = 0; r < 16; ++r) S[kt][r] = 0.f;
    } else {
        const float* sp = state_in + ((((size_t)(seq - 16) * 2 + l) * 2 + dir) * 6 + head) * 128 * 128 + 32 * vs + c;
#pragma unroll
        for (int kt = 0; kt < 4; ++kt)
#pragma unroll
            for (int r = 0; r < 16; ++r) S[kt][r] = sp[(size_t)(32 * kt + (r & 3) + 8 * (r >> 2) + 4 * h) * 128];
    }
    for (int n = 0; n < NC; ++n) {
        const int gc = gc0 + (dir ? NC - 1 - n : n);
        const unsigned char* blk = ws + WS_HF + (((size_t)gc * 6 + head) * 2 + dir) * HG_BLK + lane * 16;
        const float* eb = (const float*)(ws + WS_EB) + (((size_t)gc * 6 + head) * 2 + dir) * 128;
        bf16x8 QF[8], KF[8];
#pragma unroll
        for (int f = 0; f < 8; ++f) { QF[f] = *(const GAS bf16x8*)(blk + f * 1024); KF[f] = *(const GAS bf16x8*)(blk + 8192 + f * 1024); }
        const bf16x8 VF0 = *(const GAS bf16x8*)(blk + 24576 + (vs * 2 + 0) * 1024), VF1 = *(const GAS bf16x8*)(blk + 24576 + (vs * 2 + 1) * 1024);
        bf16x8 KTF[8];
#pragma unroll
        for (int f = 0; f < 8; ++f) KTF[f] = *(const GAS bf16x8*)(blk + 16384 + f * 1024);
        float zz = 0.f; asm volatile("" : "+v"(zz));
        f32x16 att;
#pragma unroll
        for (int r = 0; r < 16; ++r) att[r] = zz;
#pragma unroll
        for (int f = 0; f < 8; ++f) att = __builtin_amdgcn_mfma_f32_32x32x16_bf16(KF[f], QF[f], att, 0, 0, 0);
        f32x16 O;
#pragma unroll
        for (int r = 0; r < 16; ++r) O[r] = zz;
#pragma unroll
        for (int kt = 0; kt < 4; ++kt) {
            O = __builtin_amdgcn_mfma_f32_32x32x16_bf16(QF[2 * kt + 0], hg_pack8(S[kt], 0), O, 0, 0, 0);
            O = __builtin_amdgcn_mfma_f32_32x32x16_bf16(QF[2 * kt + 1], hg_pack8(S[kt], 8), O, 0, 0, 0);
        }
#pragma unroll
        for (int r = 0; r < 16; ++r) { const int j = (r & 3) + 8 * (r >> 2) + 4 * h; att[r] = j <= c ? att[r] : 0.f; }
        O = __builtin_amdgcn_mfma_f32_32x32x16_bf16(hg_pack8(att, 0), VF0, O, 0, 0, 0);
        O = __builtin_amdgcn_mfma_f32_32x32x16_bf16(hg_pack8(att, 8), VF1, O, 0, 0, 0);
#pragma unroll
        for (int r = 0; r < 16; ++r) { const int p = n * 32 + (r & 3) + 8 * (r >> 2) + 4 * h, t = dir ? T - 1 - p : p;
            HO[((size_t)dir * NTOK + base + t) * 768 + head * 128 + 32 * vs + c] = O[r]; }
#pragma unroll
        for (int kt = 0; kt < 4; ++kt) {
            S[kt] = __builtin_amdgcn_mfma_f32_32x32x16_bf16(KTF[2 * kt + 0], VF0, S[kt], 0, 0, 0);
            S[kt] = __builtin_amdgcn_mfma_f32_32x32x16_bf16(KTF[2 * kt + 1], VF1, S[kt], 0, 0, 0);
#pragma unroll
            for (int g = 0; g < 4; ++g) { const f32x4 e = *(const f32x4*)(eb + 32 * kt + 8 * g + 4 * h);
                S[kt][4 * g + 0] *= e.x; S[kt][4 * g + 1] *= e.y; S[kt][4 * g + 2] *= e.z; S[kt][4 * g + 3] *= e.w; }
        }
    }
    if (seq < 16) {
        float* sp = state_out + ((((size_t)seq * 2 + l) * 2 + dir) * 6 + head) * 128 * 128 + 32 * vs + c;
#pragma unroll
        for (int kt = 0; kt < 4; ++kt)
#pragma unroll
            for (int r = 0; r < 16; ++r) sp[(size_t)(32 * kt + (r & 3) + 8 * (r >> 2) + 4 * h) * 128] = S[kt][r];
    }
}
#define AMP_SUB_BEGIN() do { if (MK_AMP >= 0) amp_s0_ = __builtin_amdgcn_s_memrealtime(); } while (0)
#define AMP_SUB_END(code) do { if (MK_AMP == (code)) { __syncthreads(); if (threadIdx.x == 0) { const unsigned long long t1_ = __builtin_amdgcn_s_memrealtime(), dt_ = (t1_ - amp_s0_) * MK_AMPK; \
        while (__builtin_amdgcn_s_memrealtime() - t1_ < dt_) __builtin_amdgcn_s_sleep(32); } __syncthreads(); } } while (0)
__global__ void __launch_bounds__(NWAVES * 64, 2) mega(Args args) {
    extern __shared__ __attribute__((aligned(16))) unsigned char lds_raw[];
    LAS unsigned char* lds = (LAS unsigned char*)lds_raw;
    volatile LAS unsigned* MISC = (volatile LAS unsigned*)(lds + MISC_OFF);
    const int tid_k = threadIdx.x;
    const int G = gridDim.x; const int vcu = (G % 8 == 0) ? ((int)blockIdx.x % 8) * (G / 8) + (int)blockIdx.x / 8 : (int)blockIdx.x;
    unsigned char* ws = args.ws;
    gu32* ctl = (gu32*)(ws + WS_CTL);
    for (int u = tid_k; u < (LDS_BYTES - LDSCTL_OFF) / 4; u += NWAVES * 64) ((LAS unsigned*)(lds + LDSCTL_OFF))[u] = 0u;
    __syncthreads();
    XcdBarrier bar; bar.bar = (unsigned*)(ctl + CW_BAR); bar.x = 0; bar.st = nullptr;
    if (!MK_PER_PHASE) bar = xcd_barrier_post((unsigned*)(ctl + CW_BAR), MISC + 8);

    float* x = args.out;
    float* out_srw = args.out + (size_t)NTOK * DM;
    float* out_shg = out_srw + (size_t)16 * 2 * 2 * 12 * 64 * 64;
    const float* MOD = (const float*)(ws + WS_MOD);
    bf16* H = (bf16*)(ws + WS_H); bf16* Gb = (bf16*)(ws + WS_G); float* Z = (float*)(ws + WS_Z); bf16* O = (bf16*)(ws + WS_O);

#if MK_AMP >= 0
    unsigned long long amp_t0 = __builtin_amdgcn_s_memrealtime();
#endif
    for (int ph = args.ph_lo; ph < args.ph_hi; ++ph) {
        const int nrep = (MK_REP_S >= 0 && ((ph == 0 && MK_REP_S == 100) || (ph > 0 && ph < N_PHASES - 1 && (ph - 1) % 12 == MK_REP_S))) ? 2 : 1;
        for (int rep = 0; rep < nrep; ++rep) {
        int tid = threadIdx.x; asm volatile("" : "+v"(tid));
        const int lane = tid & 63, wave = __builtin_amdgcn_readfirstlane(tid >> 6);
        if (ph == 0) {
            phase_prologue(args, lds, tid, lane, wave, vcu, G);
        } else if (ph == N_PHASES - 1) {
            phase_norm(x, args.in[30], nullptr, 0, nullptr, x, lane, wave, vcu, G);
        } else {
            const int l = (ph - 1) / 12, s = (ph - 1) % 12;
            const float* mod = MOD + (size_t)l * 3 * NMODC;
            if (s == 0 || s == 3 || s == 9) {
                const int i = s == 0 ? 0 : (s == 3 ? 1 : 2);
                phase_norm(x, args.in[6] + (size_t)(l * 3 + i) * DM, mod, 3 * i, H, nullptr, lane, wave, vcu, G);
            } else if (s == 1 || s == 10) {
                const int i = s == 1 ? 0 : 1;
                pg8::Gemm g{H, (const bf16*)(ws + WS_W13 + (size_t)(l * 2 + i) * SZ_W13), NTOK, 2 * DFF, DM}; pg8::StaticOrder S; S.init(NTOK, 2 * DFF, G, (int)blockIdx.x);
                pg8::EpiSwiglu E{Gb, DFF};
                pg8::gemm_phase<pg8::EpiSwiglu, pg8::StaticOrder, true, true>(lds, g, S, E);
            } else if (s == 2 || s == 8 || s == 11) {
                pg8::Gemm g; float scale; int gi;
                if (s == 8) { g = pg8::Gemm{O, (const bf16*)(ws + WS_WOUT + (size_t)l * SZ_WOUT), NTOK, DM, DM}; scale = 1.f; gi = 5; }
                else { const int i = s == 2 ? 0 : 1; g = pg8::Gemm{Gb, (const bf16*)(ws + WS_W2 + (size_t)(l * 2 + i) * SZ_W2), NTOK, DM, DFF}; scale = 0.5f; gi = s == 2 ? 2 : 8; }
                pg8::StaticOrder S; S.init(NTOK, DM, G, (int)blockIdx.x);
                pg8::EpiResid E{x, DM, mod + (size_t)gi * DM, NMODC, scale};
                pg8::gemm_phase<pg8::EpiResid, pg8::StaticOrder, true, true>(lds, g, S, E);
            } else if (s == 4) {
                pg8::Gemm g{H, (const bf16*)(ws + WS_WIN + (size_t)l * SZ_WIN), NTOK, ZLD, DM}; pg8::StaticOrder S; S.init(NTOK, ZLD, G, (int)blockIdx.x);
                pg8::EpiStoreF32 E{Z, ZLD};
                pg8::gemm_phase<pg8::EpiStoreF32, pg8::StaticOrder, true, true>(lds, g, S, E);
            } else if (s == 5) {
                unsigned long long amp_s0_ = 0; (void)amp_s0_;
                AMP_SUB_BEGIN();
                for (int rr = 0; rr < (MK_REP_S == 50 ? 2 : 1); ++rr)
                for (int item = vcu; item < (NTOK / 128) * 4; item += G)
                    chunk_mlp_item(Z, args.in[14] + (size_t)l * 512, args.in[15] + (size_t)l * 4 * 128 * 128, args.in[16] + (size_t)l * 512, O, lds, item, tid, lane, wave);
                const RwkvW P{args.in[17] + (size_t)l * 2688, args.in[18] + (size_t)l * 2 * BWD, args.in[19] + (size_t)l * 2 * 64 * BWD, args.in[20] + (size_t)l * 2 * BWD,
                              args.in[21] + (size_t)l * 2 * 64 * BWD, args.in[22] + (size_t)l * 128 * BWD, args.in[23] + (size_t)l * BWD, args.in[24] + (size_t)l * BWD, args.in[25] + (size_t)l * BWD};
                AMP_SUB_END(50); AMP_SUB_BEGIN();
                for (int rr = 0; rr < (MK_REP_S == 51 ? 2 : 1); ++rr)
                for (int item = vcu; item < NTOK / 8; item += G) rwkv_prep_item(Z, P, ws, lds, item, tid, lane);
                AMP_SUB_END(51); AMP_SUB_BEGIN();
                for (int rr = 0; rr < (MK_REP_S == 52 ? 2 : 1); ++rr)
                for (int item = vcu; item < (NTOK / 32) * 6; item += G) hgrn_prep_item(Z, args.in[28], l, ws, lds, item, tid);
                AMP_SUB_END(52);
            } else if (s == 6) {
                LAS unsigned char* wl = lds + wave * 12288;
                const unsigned long long sc_t0 = (MK_AMP >= 60 && MK_AMP <= 62) ? __builtin_amdgcn_s_memrealtime() : 0ull;
                int sc_role = -1;
                if (wave < 4) {
                    const int slot = vcu * 4 + wave;
                    if (slot < 384) { sc_role = 60; rwkv_scan_wave_l8(ws, args.in[2], out_srw, l, 384 + (slot >> 3), slot & 7, wl, lane); }
                    else { sc_role = 61; rwkv_scan_wave<4>(ws, args.in[2], out_srw, l, (slot - 384) >> 2, (slot - 384) & 3, wl, lane); }
                } else {
                    const int b = vcu * 4 + (wave - 4), hs = (b + 512) & 1023;
                    if (hs < 96) hgrn_scan_wave(ws, args.in[3], out_shg, l, 192 + (hs >> 2), hs & 3, lane);
                    else {
                        if (hs < 864) hgrn_scan_wave(ws, args.in[3], out_shg, l, (hs - 96) >> 2, (hs - 96) & 3, lane);
                        const int idx = 640 + (b < 512 ? b : b - 96);
                        if (idx < 1536) rwkv_scan_wave<4>(ws, args.in[2], out_srw, l, idx >> 2, idx & 3, wl, lane);
                    }
                }
                if ((MK_AMP == 60 || MK_AMP == 61) && sc_role == MK_AMP) { if (lane == 0) { const unsigned long long t1_ = __builtin_amdgcn_s_memrealtime(), dt_ = (t1_ - sc_t0) * MK_AMPK; while (__builtin_amdgcn_s_memrealtime() - t1_ < dt_) __builtin_amdgcn_s_sleep(32); } }
            } else if (s == 7) {
                const int gw = vcu * NWAVES + wave, NGW = G * NWAVES;
                for (int it = gw; it < NTOK * 3; it += NGW) rwkv_post_item4(ws, args.in[26] + (size_t)l * BWD, args.in[27] + (size_t)l * BWD, O, it, lane);
                for (int it = gw; it < NTOK * 3; it += NGW) hgrn_post_item2(Z, ws, args.in[29] + (size_t)l * 128, O, it, lane);
            }
        }
        }
        if (ph + 1 < args.ph_hi) xcd_barrier(bar);
#if MK_AMP >= 0
        {
            const int s_ = (ph - 1) % 12;
            const bool hit = (MK_AMP == 0) ? (ph == 0) : (ph > 0 && ph < N_PHASES - 1 && ((MK_AMP == 1 && (s_ == 0 || s_ == 3 || s_ == 9)) || (MK_AMP == 2 && (s_ == 1 || s_ == 10)) || (MK_AMP == 3 && (s_ == 2 || s_ == 11)) ||
                              (MK_AMP >= 4 && MK_AMP <= 8 && s_ == MK_AMP)));
            if (blockIdx.x == 0 && hit) {
                if (threadIdx.x == 0) { const unsigned long long t1 = __builtin_amdgcn_s_memrealtime(), dt = (t1 - amp_t0) * MK_AMPK; while (__builtin_amdgcn_s_memrealtime() - t1 < dt) __builtin_amdgcn_s_sleep(32); }
                __syncthreads();
            }
            amp_t0 = __builtin_amdgcn_s_memrealtime();
        }
#endif
    }
}

extern "C" void kernel_launch(void* const* d_in, const int* in_sizes, int n_in, void* d_out, int out_size, void* d_ws, size_t ws_size, hipStream_t stream) {
    static int grid = 0;
    if (grid == 0) {
        if (n_in != 31 || ws_size < WS_END) { fprintf(stderr, "kernel_launch: built for 31 inputs and >= %zu bytes of workspace; got n_in %d, ws %zu; nothing launched\n", (size_t)WS_END, n_in, ws_size); grid = -1; return; }
        int dev = 0, cus = 0, per_cu = 0;
        if (hipGetDevice(&dev) != hipSuccess || hipDeviceGetAttribute(&cus, hipDeviceAttributeMultiprocessorCount, dev) != hipSuccess) { fprintf(stderr, "kernel_launch: device query failed\n"); grid = -1; return; }
        if (hipFuncSetAttribute((const void*)mega, hipFuncAttributeMaxDynamicSharedMemorySize, LDS_BYTES) != hipSuccess) { fprintf(stderr, "kernel_launch: hipFuncSetAttribute failed\n"); grid = -1; return; }
        if (hipOccupancyMaxActiveBlocksPerMultiprocessor(&per_cu, (const void*)mega, NWAVES * 64, LDS_BYTES) != hipSuccess || per_cu < 1)
            fprintf(stderr, "kernel_launch: note: occupancy query reports %d workgroups per CU\n", per_cu);
        (void)hipGetLastError();
        grid = cus;
    }
    if (grid < 0) return;
    if (hipMemsetAsync((char*)d_ws + WS_CTL, 0, CTL_ZERO_BYTES, stream) != hipSuccess) { fprintf(stderr, "kernel_launch: hipMemsetAsync failed\n"); return; }
    Args a{};
    for (int i = 0; i < 31; ++i) a.in[i] = (const float*)d_in[i];
    a.out = (float*)d_out; a.ws = (unsigned char*)d_ws;
#if MK_PER_PHASE
    for (int ph = 0; ph < N_PHASES; ++ph) { a.ph_lo = ph; a.ph_hi = ph + 1; a.li = 0; hipLaunchKernelGGL(mega, dim3(grid), dim3(NWAVES * 64), LDS_BYTES, stream, a); }
#else
    a.ph_lo = 0; a.ph_hi = N_PHASES; a.li = 0;
    hipLaunchKernelGGL(mega, dim3(grid), dim3(NWAVES * 64), LDS_BYTES, stream, a);
#endif
    const hipError_t le = hipPeekAtLastError();
    if (le != hipSuccess) fprintf(stderr, "kernel_launch: launch failed: %s\n", hipGetErrorName(le));
}
```

```cpp
#include <hip/hip_runtime.h>
#include <cstdio>
#include <cstdint>
namespace pg8 {
#define PG8_LAS __attribute__((address_space(3)))
typedef unsigned short bf16_t;
typedef short bf16x8 __attribute__((ext_vector_type(8)));
typedef float f32x4 __attribute__((ext_vector_type(4)));
typedef unsigned u32x4 __attribute__((ext_vector_type(4)));
constexpr int BM = 256, BK = 64, HALF = 128, HTB = HALF * BK * 2  , STAGE_BYTES = 8 * HTB, NXCD = 8, WGM = 8;

__host__ __device__ __forceinline__ int lds_byte(int r, int c) { const int st = (r >> 4) * 2 + (c >> 5), rr = r & 15, cc = c & 31, ob = rr * 64 + cc * 2; return st * 1024 + (ob ^ (((ob >> 9) & 1) << 5)); }
__host__ __device__ __forceinline__ void stage_rc(int b, int& R, int& C) { const int st = b / 1024, sb = b % 1024, swz = sb ^ (((sb >> 9) & 1) << 5); R = (st >> 1) * 16 + swz / 64; C = (st & 1) * 32 + (swz % 64) / 2; }
__host__ __device__ __forceinline__ int perm32(int rho) { const int n = rho >> 4, i = rho & 15; return 8 * (i >> 2) + 4 * n + (i & 3); }

struct Unit { int pm, pn; };
struct Gemm { const bf16_t* A; const bf16_t* Bt; int M, N, K; };

struct StaticOrder {
    int nM, nN, nwg, G, c;
    __host__ __device__ void init(int M, int N, int G_, int c_) { nM = M / BM; nN = N / BM; nwg = nM * nN; G = G_; c = c_; }
    __host__ __device__ bool next(int i, Unit& u) const {
        const long L = (long)i * G + c; if (L >= nwg) return false;
        int wgid = (int)L; { const int q = nwg / NXCD, r = nwg % NXCD, xcd = wgid % NXCD, off = wgid / NXCD; wgid = (xcd < r ? xcd * (q + 1) : r * (q + 1) + (xcd - r) * q) + off; }
        const int nig = WGM * nN, gid = wgid / nig, fm = gid * WGM, gsz = (nM - fm) < WGM ? (nM - fm) : WGM;
        u.pm = fm + ((wgid % nig) % gsz); u.pn = (wgid % nig) / gsz; return true;
    }
    __device__ __forceinline__ void a_ready(const Unit&) const {}
    __device__ __forceinline__ void done(const Unit&) const {}
};

__device__ __forceinline__ unsigned cvt_pk_bf16(float lo, float hi) { unsigned r; asm volatile("v_cvt_pk_bf16_f32 %0, %1, %2" : "=v"(r) : "v"(lo), "v"(hi)); return r; }
typedef float f32x2 __attribute__((ext_vector_type(2)));
__device__ __forceinline__ float silu_f(float x) { return x / (1.f + __expf(-x)); }
struct EpiSwiglu {
    static constexpr bool PERM = true, AFTER_DRAIN = false;
    bf16_t* O; int ldc;
    __device__ __forceinline__ void operator()(const f32x4 (&acc)[2][2][4][2], const Unit& u, int wr, int wc, int fr, int fq) const {
        const int row0 = u.pm * BM + wr * 64 + fr, col0 = u.pn * HALF + wc * 32 + 8 * fq;
#pragma unroll
        for (int ai = 0; ai < 2; ++ai)
#pragma unroll
            for (int m = 0; m < 4; ++m) { bf16_t* rowp = O + (size_t)(row0 + ai * HALF + m * 16) * ldc + col0;
                const f32x4 a0 = acc[ai][0][m][0], a1 = acc[ai][0][m][1], g0 = acc[ai][1][m][0], g1 = acc[ai][1][m][1];
                u32x4 w; w.x = cvt_pk_bf16(silu_f(a0[0]) * g0[0], silu_f(a0[1]) * g0[1]); w.y = cvt_pk_bf16(silu_f(a0[2]) * g0[2], silu_f(a0[3]) * g0[3]);
                w.z = cvt_pk_bf16(silu_f(a1[0]) * g1[0], silu_f(a1[1]) * g1[1]); w.w = cvt_pk_bf16(silu_f(a1[2]) * g1[2], silu_f(a1[3]) * g1[3]);
                *(u32x4*)rowp = w; }
    }
};
struct EpiResid {
    static constexpr bool PERM = false, AFTER_DRAIN = false;
    float* X; int ldc; const float* gate_base; int gate_stride; float scale;
    __device__ __forceinline__ void operator()(const f32x4 (&acc)[2][2][4][2], const Unit& u, int wr, int wc, int fr, int fq) const {
        const int rt = u.pm * BM; const int cond = rt < 4096 ? 0 : 1 + ((rt - 4096) >> 10);
        const float* gate = gate_base + (size_t)cond * gate_stride;
        const int col0 = u.pn * BM + wc * 32 + 4 * fq;
#pragma unroll
        for (int bj = 0; bj < 2; ++bj)
#pragma unroll
            for (int n = 0; n < 2; ++n) { const int c = col0 + bj * HALF + n * 16; const f32x4 gv = *(const f32x4*)(gate + c) * scale;
#pragma unroll
                for (int ai = 0; ai < 2; ++ai)
#pragma unroll
                    for (int m = 0; m < 4; ++m) { float* p = X + (size_t)(rt + ai * HALF + wr * 64 + m * 16 + fr) * ldc + c;
                        const f32x4 old = *(const f32x4*)p; *(f32x4*)p = old + gv * acc[ai][bj][m][n]; } }
    }
};
struct EpiStoreF32 {
    static constexpr bool PERM = false, AFTER_DRAIN = false;
    float* Z; int ldc;
    __device__ __forceinline__ void operator()(const f32x4 (&acc)[2][2][4][2], const Unit& u, int wr, int wc, int fr, int fq) const {
        const int col0 = u.pn * BM + wc * 32 + 4 * fq;
#pragma unroll
        for (int ai = 0; ai < 2; ++ai)
#pragma unroll
            for (int m = 0; m < 4; ++m) { float* rowp = Z + (size_t)(u.pm * BM + ai * HALF + wr * 64 + m * 16 + fr) * ldc + col0;
#pragma unroll
                for (int bj = 0; bj < 2; ++bj)
#pragma unroll
                    for (int n = 0; n < 2; ++n) *(f32x4*)(rowp + bj * HALF + n * 16) = acc[ai][bj][m][n]; }
    }
};
template <class Epi, class Sched, bool ALIGN_EPI = false, bool SP2 = false>
__device__ __forceinline__ void gemm_phase(PG8_LAS unsigned char* lds, const Gemm g, const Sched& S, const Epi& E) {
    int tid0_ = threadIdx.x; asm volatile("" : "+v"(tid0_));
    const int tid = tid0_, wid = __builtin_amdgcn_readfirstlane(tid >> 6), lane = tid & 63, wr = wid >> 2, wc = wid & 3, fr = lane & 15, fq = lane >> 4;
    const int K = g.K, nt = K / BK;
    unsigned voffA[2], voffB[2];
#pragma unroll
    for (int i = 0; i < 2; ++i) { int R, C; stage_rc(tid * 16 + i * 8192, R, C); const int Rb = Epi::PERM ? ((R & ~31) + perm32(R & 31)) : R;
        voffA[i] = (unsigned)(R * K + C) * 2u; voffB[i] = (unsigned)(Rb * K + C) * 2u; }
    const size_t kstep = (size_t)(BK * 2);
    const size_t hstep = (size_t)HALF * K * 2;
    const size_t tstep = 2 * hstep;
    const unsigned ldsw = (unsigned)wid * 1024u;
    const int aoff = lds_byte(wr * 64 + fr, fq * 8), boff = lds_byte(wc * 32 + fr, fq * 8);
#define PG8_SA(b, h) (((b) * 2 + (h)) * HTB)
#define PG8_SB(b, h) ((4 + (b) * 2 + (h)) * HTB)
#define PG8_STAGE(bufoff, gbase, voff) do { _Pragma("unroll") for (int _i = 0; _i < 2; ++_i) \
        __builtin_amdgcn_global_load_lds((const unsigned*)((const char*)(gbase) + (voff)[_i]), (PG8_LAS unsigned*)(lds + (bufoff) + ldsw + _i * 8192), 16, 0, 0); } while (0)
#define PG8_LDA(dst, b, h) do { _Pragma("unroll") for (int m = 0; m < 4; ++m) _Pragma("unroll") for (int k = 0; k < 2; ++k) dst[m][k] = *(const PG8_LAS bf16x8*)(lds + PG8_SA(b, h) + aoff + m * 2048 + k * 1024); } while (0)
#define PG8_LDB(dst, b, h) do { _Pragma("unroll") for (int n = 0; n < 2; ++n) _Pragma("unroll") for (int k = 0; k < 2; ++k) dst[n][k] = *(const PG8_LAS bf16x8*)(lds + PG8_SB(b, h) + boff + n * 2048 + k * 1024); } while (0)
#define PG8_MMA(ai, bj, At, Bt) do { __builtin_amdgcn_s_setprio(1); _Pragma("unroll") for (int m = 0; m < 4; ++m) _Pragma("unroll") for (int n = 0; n < 2; ++n) _Pragma("unroll") for (int k = 0; k < 2; ++k) \
        acc[ai][bj][m][n] = __builtin_amdgcn_mfma_f32_16x16x32_bf16(Bt[n][k], At[m][k], acc[ai][bj][m][n], 0, 0, 0); __builtin_amdgcn_s_setprio(0); } while (0)
#define PG8_WAIT_V(n) asm volatile("s_waitcnt vmcnt(" #n ")" ::: "memory")
#define PG8_WAIT_L(n) asm volatile("s_waitcnt lgkmcnt(" #n ")" ::: "memory")
#define PG8_BAR __builtin_amdgcn_s_barrier()
#define PG8_SCHED __builtin_amdgcn_sched_barrier(0)
    Unit cur, nxt; int ui = 0;
    if (!S.next(0, cur)) return;
    f32x4 acc[2][2][4][2];
#pragma unroll
    for (int a = 0; a < 2; ++a)
#pragma unroll
        for (int b = 0; b < 2; ++b)
#pragma unroll
            for (int m = 0; m < 4; ++m)
#pragma unroll
                for (int n = 0; n < 2; ++n) acc[a][b][m][n] = (f32x4){0.f, 0.f, 0.f, 0.f};
    bf16x8 At[4][2], B0[2][2], B1[2][2];
    const char* cA = (const char*)g.A + (size_t)cur.pm * tstep; const char* cB = (const char*)g.Bt + (size_t)cur.pn * tstep;
    S.a_ready(cur);
    if constexpr (SP2) {
        PG8_STAGE(PG8_SB(0, 0), cB, voffB); PG8_STAGE(PG8_SB(0, 1), cB + hstep, voffB); PG8_STAGE(PG8_SA(0, 0), cA, voffA); PG8_STAGE(PG8_SA(0, 1), cA + hstep, voffA);
        if (wr == 1) PG8_BAR;
        PG8_WAIT_V(2); PG8_BAR;
        PG8_STAGE(PG8_SB(1, 0), cB + kstep, voffB); PG8_STAGE(PG8_SA(1, 0), cA + kstep, voffA); PG8_STAGE(PG8_SB(1, 1), cB + hstep + kstep, voffB);
        PG8_WAIT_V(6); PG8_BAR;
    } else {
        PG8_STAGE(PG8_SB(0, 0), cB, voffB); PG8_STAGE(PG8_SA(0, 0), cA, voffA); PG8_STAGE(PG8_SB(0, 1), cB + hstep, voffB); PG8_STAGE(PG8_SA(0, 1), cA + hstep, voffA);
        if (wr == 1) PG8_BAR;
        PG8_WAIT_V(4); PG8_BAR;
        PG8_STAGE(PG8_SB(1, 0), cB + kstep, voffB); PG8_STAGE(PG8_SA(1, 0), cA + kstep, voffA); PG8_STAGE(PG8_SB(1, 1), cB + hstep + kstep, voffB);
        PG8_WAIT_V(6); PG8_BAR;
    }
    for (;;) {
        const bool has_next = S.next(ui + 1, nxt);
        const char* nA = has_next ? (const char*)g.A + (size_t)nxt.pm * tstep : cA; const char* nB = has_next ? (const char*)g.Bt + (size_t)nxt.pn * tstep : cB;
        for (int t = 0; t < nt; t += 2) {
            const bool last = (t == nt - 2);
            const char* a1 = cA + (size_t)(t + 1) * kstep;
            const char* a2 = last ? nA : cA + (size_t)(t + 2) * kstep; const char* b2 = last ? nB : cB + (size_t)(t + 2) * kstep;
            const char* a3 = a2 + kstep; const char* b3 = b2 + kstep;
            if (last && has_next) S.a_ready(nxt);
            if constexpr (SP2) {
            PG8_LDB(B0, 0, 0); PG8_LDB(B1, 0, 1); PG8_SCHED; PG8_LDA(At, 0, 0); PG8_STAGE(PG8_SA(1, 1), a1 + hstep, voffA);
            PG8_WAIT_V(8); PG8_WAIT_L(0); PG8_BAR; PG8_MMA(0, 0, At, B0); PG8_MMA(0, 1, At, B1); PG8_BAR; PG8_SCHED;
            PG8_LDA(At, 0, 1); PG8_STAGE(PG8_SB(0, 0), b2, voffB); PG8_STAGE(PG8_SB(0, 1), b2 + hstep, voffB); PG8_STAGE(PG8_SA(0, 0), a2, voffA);
            PG8_WAIT_V(8); PG8_WAIT_L(0); PG8_BAR; PG8_MMA(1, 0, At, B0); PG8_MMA(1, 1, At, B1); PG8_BAR; PG8_SCHED;
            PG8_LDB(B0, 1, 0); PG8_LDB(B1, 1, 1); PG8_SCHED; PG8_LDA(At, 1, 0); PG8_STAGE(PG8_SA(0, 1), a2 + hstep, voffA);
            PG8_WAIT_V(8); PG8_WAIT_L(0); PG8_BAR; PG8_MMA(0, 0, At, B0); PG8_MMA(0, 1, At, B1); PG8_BAR; PG8_SCHED;
            PG8_LDA(At, 1, 1); PG8_STAGE(PG8_SB(1, 0), b3, voffB); PG8_STAGE(PG8_SB(1, 1), b3 + hstep, voffB); PG8_STAGE(PG8_SA(1, 0), a3, voffA);
            PG8_WAIT_V(8); PG8_WAIT_L(0); PG8_BAR; PG8_MMA(1, 0, At, B0); PG8_MMA(1, 1, At, B1); PG8_BAR; PG8_SCHED;
            } else {
            PG8_LDB(B0, 0, 0); PG8_SCHED; PG8_LDA(At, 0, 0); PG8_STAGE(PG8_SA(1, 1), a1 + hstep, voffA);
            PG8_WAIT_L(8); PG8_BAR; PG8_WAIT_L(0); PG8_MMA(0, 0, At, B0); PG8_BAR; PG8_SCHED;
            PG8_LDB(B1, 0, 1); PG8_STAGE(PG8_SB(0, 0), b2, voffB);
            PG8_BAR; PG8_WAIT_L(0); PG8_MMA(0, 1, At, B1); PG8_BAR;
            PG8_LDA(At, 0, 1); PG8_STAGE(PG8_SA(0, 0), a2, voffA);
            PG8_BAR; PG8_WAIT_L(0); PG8_MMA(1, 0, At, B0); PG8_BAR; PG8_SCHED;
            PG8_STAGE(PG8_SB(0, 1), b2 + hstep, voffB);
            PG8_WAIT_V(6); PG8_BAR; PG8_MMA(1, 1, At, B1); PG8_BAR;
            PG8_LDB(B0, 1, 0); PG8_SCHED; PG8_LDA(At, 1, 0); PG8_STAGE(PG8_SA(0, 1), a2 + hstep, voffA);
            PG8_WAIT_L(8); PG8_BAR; PG8_WAIT_L(0); PG8_MMA(0, 0, At, B0); PG8_BAR; PG8_SCHED;
            PG8_LDB(B1, 1, 1); PG8_STAGE(PG8_SB(1, 0), b3, voffB);
            PG8_BAR; PG8_WAIT_L(0); PG8_MMA(0, 1, At, B1); PG8_BAR;
            PG8_LDA(At, 1, 1); PG8_STAGE(PG8_SA(1, 0), a3, voffA);
            PG8_BAR; PG8_WAIT_L(0); PG8_MMA(1, 0, At, B0); PG8_BAR; PG8_SCHED;
            PG8_STAGE(PG8_SB(1, 1), b3 + hstep, voffB);
            PG8_WAIT_V(6); PG8_BAR; PG8_MMA(1, 1, At, B1); PG8_BAR;
            }
        }
        if constexpr (ALIGN_EPI) { if (wr == 0) PG8_BAR; }
        if constexpr (!Epi::AFTER_DRAIN) { E(acc, cur, wr, wc, fr, fq); S.done(cur); }
        if (!has_next) break;
#pragma unroll
        for (int a = 0; a < 2; ++a)
#pragma unroll
            for (int b = 0; b < 2; ++b)
#pragma unroll
                for (int m = 0; m < 4; ++m)
#pragma unroll
                    for (int n = 0; n < 2; ++n) acc[a][b][m][n] = (f32x4){0.f, 0.f, 0.f, 0.f};
        cur = nxt; cA = nA; cB = nB; ++ui;
        if constexpr (ALIGN_EPI) { if (wr == 1) PG8_BAR; }
    }
    PG8_WAIT_V(0);
    if constexpr (!ALIGN_EPI) { if (wr == 0) PG8_BAR; }
    PG8_BAR;
    if constexpr (Epi::AFTER_DRAIN) { E.fused(acc, cur, wr, wc, fr, fq, lds, wid, lane); S.done(cur); }
#undef PG8_SA
#undef PG8_SB
#undef PG8_STAGE
#undef PG8_LDA
#undef PG8_LDB
#undef PG8_MMA
#undef PG8_WAIT_V
#undef PG8_WAIT_L
#undef PG8_BAR
#undef PG8_SCHED
}
}
#define GAS __attribute__((address_space(1)))
#define LAS __attribute__((address_space(3)))
typedef unsigned short bf16;
typedef unsigned v4u __attribute__((ext_vector_type(4)));
typedef float f32x4 __attribute__((ext_vector_type(4)));
typedef short bf16x8 __attribute__((ext_vector_type(8)));
typedef GAS unsigned gu32;
typedef GAS unsigned long long gu64;
#define RLX_AGENT __ATOMIC_RELAXED, __HIP_MEMORY_SCOPE_AGENT
#define LDS_WAIT() asm volatile("s_waitcnt lgkmcnt(0)" ::: "memory")
#define VM_WAIT() asm volatile("s_waitcnt vmcnt(0)" ::: "memory")
__device__ __forceinline__ unsigned long long rt() { return __builtin_amdgcn_s_memrealtime(); }
__device__ __forceinline__ unsigned f2bf(float f) { unsigned u = __builtin_bit_cast(unsigned, f); return (u + 0x7fffu + ((u >> 16) & 1u)) >> 16; }
__device__ __forceinline__ unsigned pk2(float lo, float hi) { return f2bf(lo) | (f2bf(hi) << 16); }
#define XB_TMO      128
#define XB_XCNT(j)  (256  + 64 * (j))
#define XB_XSUB(j)  (1280 + 64 * (j))
#define XB_XGEN(j)  (2304 + 64 * (j))
#define XB_TOP      3328
#define XB_TOPGEN   3392
#define XCD_BAR_WORDS 3456
#define XB_SPIN_CAP (1u << 18)

__device__ __forceinline__ unsigned xb_ld(unsigned* p)              { return __hip_atomic_load(p, __ATOMIC_RELAXED, __HIP_MEMORY_SCOPE_AGENT); }
__device__ __forceinline__ unsigned xb_add(unsigned* p, unsigned v) { return __hip_atomic_fetch_add(p, v, __ATOMIC_RELAXED, __HIP_MEMORY_SCOPE_AGENT); }
__device__ __forceinline__ unsigned xb_xcc_id() { return (unsigned)__builtin_amdgcn_s_getreg((3 << 11) | 20) & 0xFu; }
#define XB_SPIN(cond, bar) do { unsigned _sp = 0; while (cond) { __builtin_amdgcn_s_sleep(1); \
    if ((++_sp & 255u) == 0u) { if (xb_ld(&(bar)[XB_TMO])) break; if (_sp > XB_SPIN_CAP) { atomicAdd(&(bar)[XB_TMO], 1u); break; } } } } while (0)

struct XcdBarrier {
    unsigned* bar; unsigned x;
    volatile LAS unsigned* st;
};

__device__ __forceinline__ XcdBarrier xcd_barrier_post(unsigned* bar, volatile LAS unsigned* st) {
    XcdBarrier b; b.bar = bar; b.x = xb_xcc_id(); b.st = st;
    if (threadIdx.x == 0) (void)xb_add(&bar[XB_XCNT(b.x)], 1u);
    return b;
}
__device__ __forceinline__ void xcd_barrier_complete(unsigned* bar, unsigned x, unsigned& nloc, unsigned& nx) {
    const unsigned G = gridDim.x * gridDim.y * gridDim.z;
    unsigned sum, cnt, mine, sp = 0u;
    for (;;) {
        sum = 0u; cnt = 0u; mine = 0u;
#pragma unroll
        for (unsigned j = 0; j < 16; ++j) { const unsigned c = xb_ld(&bar[XB_XCNT(j)]); sum += c; cnt += (c > 0u) ? 1u : 0u; mine = (j == x) ? c : mine; }
        if (sum == G) break;
        __builtin_amdgcn_s_sleep(1);
        if ((++sp & 255u) == 0u) { if (xb_ld(&bar[XB_TMO])) break; if (sp > XB_SPIN_CAP) { atomicAdd(&bar[XB_TMO], 1u); break; } }
    }
    nloc = mine > 0u ? mine : 1u; nx = cnt > 0u ? cnt : 1u;
}

__device__ __forceinline__ void xcd_barrier(const XcdBarrier& b) {
    asm volatile("s_waitcnt vmcnt(0)" ::: "memory");
    __syncthreads();
    if (threadIdx.x == 0) {
        unsigned* bar = b.bar;
        __builtin_amdgcn_s_waitcnt(0);
        unsigned nloc = b.st[0], nx = b.st[1];
        if (nloc == 0u) { xcd_barrier_complete(bar, b.x, nloc, nx); b.st[0] = nloc; b.st[1] = nx; }
        const unsigned old = xb_add(&bar[XB_XSUB(b.x)], 1u);
        const unsigned gen = old / nloc;
        if (old + 1u == (gen + 1u) * nloc) {
            __builtin_amdgcn_fence(__ATOMIC_RELEASE, "agent");
            asm volatile("s_waitcnt vmcnt(0)" ::: "memory");
            const unsigned og = xb_add(&bar[XB_TOP], 1u);
            const unsigned tg = og / nx;
            if (og + 1u == (tg + 1u) * nx) xb_add(&bar[XB_TOPGEN], 1u);
            else XB_SPIN(xb_ld(&bar[XB_TOPGEN]) == tg, bar);
            __builtin_amdgcn_fence(__ATOMIC_ACQUIRE, "agent");
            xb_add(&bar[XB_XGEN(b.x)], 1u);
            asm volatile("s_waitcnt vmcnt(0)" ::: "memory");
        } else {
            XB_SPIN(xb_ld(&bar[XB_XGEN(b.x)]) == gen, bar);
            __builtin_amdgcn_fence(__ATOMIC_ACQUIRE, "agent");
            asm volatile("s_waitcnt vmcnt(0)" ::: "memory");
        }
    }
    __syncthreads();
}
constexpr int NWAVES = 8;
#ifndef MK_REP_S
#define MK_REP_S -1
#endif
#ifndef MK_AMP
#define MK_AMP -1
#endif
#ifndef MK_AMPK
#define MK_AMPK 4
#endif
#ifndef MK_PER_PHASE
#define MK_PER_PHASE 0
#endif
constexpr int DM = 2048, NTOK = 6144, DFF = 5632, INC = 7552, ZLD = 7680, BWD = 768, NMODC = 18432;
constexpr int ZB0 = 1024, ZC0 = 3712;
constexpr int N_PHASES = 26;
constexpr size_t MiB = 1u << 20;
constexpr size_t WS_CTL = 0, CTL_ZERO_BYTES = 1 * MiB;
constexpr size_t WS_MOD = 1 * MiB;
constexpr size_t WS_W13 = 2 * MiB, SZ_W13 = 44 * MiB;
constexpr size_t WS_W2 = WS_W13 + 4 * SZ_W13, SZ_W2 = 22 * MiB;
constexpr size_t WS_WIN = WS_W2 + 4 * SZ_W2, SZ_WIN = 30 * MiB;
constexpr size_t WS_WOUT = WS_WIN + 2 * SZ_WIN, SZ_WOUT = 8 * MiB;
constexpr size_t WS_H = WS_WOUT + 2 * SZ_WOUT;
constexpr size_t WS_G = WS_H + 24 * MiB;
constexpr size_t WS_Z = WS_G + 66 * MiB;
constexpr size_t WS_O = WS_Z + 180 * MiB;
constexpr size_t SZ_T = 18 * MiB;
constexpr size_t WS_R = WS_O + 24 * MiB, WS_V = WS_R + SZ_T, WS_KK = WS_V + SZ_T, WS_GATE = WS_KK + SZ_T;
constexpr size_t WS_W = WS_GATE + SZ_T, WS_KD = WS_W + 2 * SZ_T, WS_BV = WS_KD + 2 * SZ_T, WS_Y = WS_BV + 2 * SZ_T;
constexpr size_t WS_BON = WS_Y + 2 * SZ_T;
constexpr size_t WS_QS = WS_BON + 1 * MiB, WS_FG = WS_QS + SZ_T, WS_HO = WS_FG + 2 * SZ_T;
constexpr size_t WS_HF = WS_HO + 2 * SZ_T, WS_EB = WS_HF + 72 * MiB, WS_LW = WS_EB + 2 * MiB, WS_END = WS_LW + 2 * MiB;
constexpr int CW_BAR = 4096;
constexpr int RING_BYTES = 135168;
constexpr int LDSCTL_OFF = 147456, MISC_OFF = LDSCTL_OFF + 320;
constexpr int LDS_BYTES = 147456 + 1024;

__device__ __forceinline__ float sigmoid_f(float x) { return 1.f / (1.f + __expf(-x)); }
__device__ __forceinline__ float silu_f(float x) { return x / (1.f + __expf(-x)); }
__device__ __forceinline__ float gelu_tanh(float x) { const float u = 0.7978845608028654f * (x + 0.044715f * x * x * x); return 0.5f * x * (1.f + tanhf(u)); }
__device__ __forceinline__ float wave_sum(float v) {
#pragma unroll
    for (int o = 1; o < 64; o <<= 1) v += __shfl_xor(v, o);
    return v;
}
#define WG_SYNC() do { asm volatile("s_waitcnt vmcnt(0) lgkmcnt(0)" ::: "memory"); __builtin_amdgcn_s_barrier(); asm volatile("" ::: "memory"); } while (0)

__device__ __forceinline__ void conv_item(const float* W, int K, int N, bf16* WT, int mode, LAS float* scr, int item, int lane) {
    const int nblk = N / 32, kb = item / nblk, nb = item % nblk, k0 = 64 * kb, n0 = 32 * nb;
#pragma unroll 8
    for (int i = 0; i < 32; ++i) { const int kk = 2 * i + (lane >> 5); scr[kk * 33 + (lane & 31)] = W[(size_t)(k0 + kk) * N + n0 + (lane & 31)]; }
    LDS_WAIT(); asm volatile("" ::: "memory");
    const int rowbase = mode == 0 ? n0 : (256 * (n0 >> 7) + (n0 & 127) + (mode == 2 ? 128 : 0));
    const int c = lane & 7;
#pragma unroll
    for (int j = 0; j < 4; ++j) { const int n = (lane >> 3) + 8 * j; const LAS float* s = scr + (8 * c) * 33 + n;
        v4u o; o.x = pk2(s[0 * 33], s[1 * 33]); o.y = pk2(s[2 * 33], s[3 * 33]); o.z = pk2(s[4 * 33], s[5 * 33]); o.w = pk2(s[6 * 33], s[7 * 33]);
        *(GAS v4u*)(WT + (size_t)(rowbase + n) * K + k0 + 8 * c) = o; }
    LDS_WAIT(); asm volatile("" ::: "memory");
}

struct Args { const float* in[31]; float* out; unsigned char* ws; int ph_lo, ph_hi, li, pad; };

__device__ __forceinline__ void conv_ffn(const Args& A, int l, int i, LAS float* scr, int gw, int NGW, int lane) {
    constexpr int I_13 = (DM / 64) * (DFF / 32), I_2 = (DFF / 64) * (DM / 32);
    const float* w1 = A.in[9] + (size_t)(l * 2 + i) * DM * DFF; const float* w3 = A.in[10] + (size_t)(l * 2 + i) * DM * DFF; const float* w2 = A.in[11] + (size_t)(l * 2 + i) * DFF * DM;
    bf16* W13 = (bf16*)(A.ws + WS_W13 + (size_t)(l * 2 + i) * SZ_W13); bf16* W2 = (bf16*)(A.ws + WS_W2 + (size_t)(l * 2 + i) * SZ_W2);
    for (int it = gw; it < I_13; it += NGW) conv_item(w1, DM, DFF, W13, 1, scr, it, lane);
    for (int it = gw; it < I_13; it += NGW) conv_item(w3, DM, DFF, W13, 2, scr, it, lane);
    for (int it = gw; it < I_2; it += NGW) conv_item(w2, DFF, DM, W2, 0, scr, it, lane);
}
__device__ __forceinline__ void conv_inout(const Args& A, int l, LAS float* scr, int gw, int NGW, int lane) {
    constexpr int I_IN = (DM / 64) * (INC / 32), I_OUT = (DM / 64) * (DM / 32);
    bf16* WIN = (bf16*)(A.ws + WS_WIN + (size_t)l * SZ_WIN); bf16* WOUT = (bf16*)(A.ws + WS_WOUT + (size_t)l * SZ_WOUT);
    for (int it = gw; it < I_IN; it += NGW) conv_item(A.in[12] + (size_t)l * DM * INC, DM, INC, WIN, 0, scr, it, lane);
    for (int it = gw; it < I_OUT; it += NGW) conv_item(A.in[13] + (size_t)l * DM * DM, DM, DM, WOUT, 0, scr, it, lane);
    for (int i = gw * 64 + lane; i < 128 * DM / 8; i += NGW * 64) ((GAS v4u*)(WIN + (size_t)INC * DM))[i] = (v4u){0u, 0u, 0u, 0u};
}
__device__ __forceinline__ void conv_set(const Args& A, int set, LAS float* scr, int gw, int NGW, int lane) {
    if (set == 0) { for (int l = 0; l < 2; ++l) {
        bf16* LW = (bf16*)(A.ws + WS_LW + (size_t)l * MiB);
        for (int it = gw; it < 144; it += NGW) {
            if (it < 48) conv_item(A.in[19] + ((size_t)l * 2 + it / 24) * 64 * BWD, 64, BWD, LW + (size_t)(it / 24) * BWD * 64, 0, scr, it % 24, lane);
            else if (it < 96) conv_item(A.in[21] + ((size_t)l * 2 + (it - 48) / 24) * 64 * BWD, 64, BWD, LW + (size_t)(2 + (it - 48) / 24) * BWD * 64, 0, scr, (it - 48) % 24, lane);
            else conv_item(A.in[22] + (size_t)l * 128 * BWD, 128, BWD, LW + (size_t)4 * BWD * 64, 0, scr, it - 96, lane);
        }
        conv_ffn(A, l, 0, scr, gw, NGW, lane); conv_ffn(A, l, 1, scr, gw, NGW, lane); conv_inout(A, l, scr, gw, NGW, lane); } }
}

__device__ __forceinline__ void phase_prologue(const Args& A, LAS unsigned char* lds, int tid, int lane, int wave, int vcu, int G) {
    unsigned char* ws = A.ws;
    conv_set(A, 0, (LAS float*)(lds + wave * 8448), vcu * NWAVES + wave, G * NWAVES, lane);
    {
        const f32x4* xp = (const f32x4*)A.in[0]; const f32x4* xs = (const f32x4*)A.in[1]; f32x4* xo = (f32x4*)A.out;
        constexpr int NP = 4096 * DM / 4, NALL = NTOK * DM / 4;
        for (int i = vcu * 512 + tid; i < NALL; i += G * 512) xo[i] = i < NP ? xp[i] : xs[i - NP];
    }
    WG_SYNC();
    {
        LAS float* sct = (LAS float*)(lds + 0);
        LAS float* red = (LAS float*)(lds + 32768);
        for (int i = tid; i < 3 * DM; i += 512) { const int cd = i / DM, k = i % DM; const float s = cd == 0 ? A.in[5][k] : A.in[4][(cd - 1) * DM + k]; sct[i] = silu_f(s); }
        WG_SYNC();
        float* MOD = (float*)(ws + WS_MOD);
        for (int item = vcu; item < 2 * (NMODC / 64); item += G) {
            const int l = item / (NMODC / 64), j0 = (item % (NMODC / 64)) * 64;
            const float* w = A.in[7] + (size_t)l * DM * NMODC + j0 + lane;
            float a0 = 0.f, a1 = 0.f, a2 = 0.f;
#pragma unroll 8
            for (int k = wave * 256; k < wave * 256 + 256; ++k) { const float wv = w[(size_t)k * NMODC]; a0 += sct[k] * wv; a1 += sct[DM + k] * wv; a2 += sct[2 * DM + k] * wv; }
            red[(wave * 3 + 0) * 64 + lane] = a0; red[(wave * 3 + 1) * 64 + lane] = a1; red[(wave * 3 + 2) * 64 + lane] = a2;
            WG_SYNC();
            if (tid < 192) { const int cd = tid >> 6; float s = A.in[8][(size_t)l * NMODC + j0 + lane];
#pragma unroll
                for (int w8 = 0; w8 < 8; ++w8) s += red[(w8 * 3 + cd) * 64 + lane];
                MOD[(size_t)(l * 3 + cd) * NMODC + j0 + lane] = s; }
            WG_SYNC();
        }
    }
}

__device__ __forceinline__ void phase_norm(const float* x, const float* g, const float* mod, int sh_idx, bf16* H, float* xout, int lane, int wave, int vcu, int G) {
    const int gw = vcu * NWAVES + wave, NGW = G * NWAVES;
    for (int m = gw; m < NTOK; m += NGW) {
        const GAS f32x4* xr = (const GAS f32x4*)(x + (size_t)m * DM) + lane;
        f32x4 v[8]; float ss = 0.f;
#pragma unroll
        for (int j = 0; j < 8; ++j) { v[j] = xr[64 * j]; ss += (v[j].x * v[j].x + v[j].y * v[j].y) + (v[j].z * v[j].z + v[j].w * v[j].w); }
        const float rstd = rsqrtf(wave_sum(ss) * (1.f / DM) + 1e-6f);
        if (mod) {
            const int cond = m < 4096 ? 0 : 1 + ((m - 4096) >> 10);
            const float* sh = mod + (size_t)cond * NMODC + sh_idx * DM; const float* sc = sh + DM;
            GAS unsigned long long* o8 = (GAS unsigned long long*)(H + (size_t)m * DM) + lane;
#pragma unroll
            for (int j = 0; j < 8; ++j) { const int col = 4 * (lane + 64 * j);
                const f32x4 g4 = *(const f32x4*)(g + col), sc4 = *(const f32x4*)(sc + col), sh4 = *(const f32x4*)(sh + col);
                const f32x4 o = v[j] * rstd * g4 * (sc4 + 1.f) + sh4;
                o8[64 * j] = (unsigned long long)pk2(o.x, o.y) | ((unsigned long long)pk2(o.z, o.w) << 32); }
        } else {
            GAS f32x4* xo = (GAS f32x4*)(xout + (size_t)m * DM) + lane;
#pragma unroll
            for (int j = 0; j < 8; ++j) { const int col = 4 * (lane + 64 * j); const f32x4 g4 = *(const f32x4*)(g + col); xo[64 * j] = v[j] * rstd * g4; }
        }
    }
}

__device__ __forceinline__ void st_bf16(bf16* p, float v) { *p = (bf16)f2bf(v); }

typedef float f32x16a __attribute__((ext_vector_type(16)));
__device__ __forceinline__ unsigned cm_cvt_pk(float lo, float hi) { unsigned r; asm("v_cvt_pk_bf16_f32 %0, %1, %2" : "=v"(r) : "v"(lo), "v"(hi)); return r; }
__device__ __forceinline__ void chunk_mlp_item(const float* z, const float* ng, const float* wsp, const float* bs, bf16* o, LAS unsigned char* lds, int item, int tid, int lane, int wave) {
    constexpr int VROW = 272;
    const int chunk = item >> 2, g = item & 3, tok0 = chunk * 128;
    const float ng0 = ng[g * 128 + lane], ng1 = ng[g * 128 + lane + 64];
    {
        float za[8][4];
#pragma unroll
        for (int i = 0; i < 8; ++i) { const float* zr = z + (size_t)(tok0 + 2 * wave + 16 * i) * ZLD + 512 + g * 128; za[i][0] = zr[lane]; za[i][1] = zr[lane + 64]; za[i][2] = zr[ZLD + lane]; za[i][3] = zr[ZLD + lane + 64]; }
#pragma unroll
        for (int i = 0; i < 8; ++i) {
            const int q = 2 * wave + 16 * i;
            const float a0 = gelu_tanh(za[i][0]), b0 = gelu_tanh(za[i][1]), a1 = gelu_tanh(za[i][2]), b1 = gelu_tanh(za[i][3]);
            const float rs0 = rsqrtf(wave_sum(a0 * a0 + b0 * b0) * (1.f / 128.f) + 1e-6f), rs1 = rsqrtf(wave_sum(a1 * a1 + b1 * b1) * (1.f / 128.f) + 1e-6f);
            *(LAS unsigned*)(lds + lane * VROW + q * 2) = pk2(a0 * rs0 * ng0, a1 * rs1 * ng0);
            *(LAS unsigned*)(lds + (lane + 64) * VROW + q * 2) = pk2(b0 * rs0 * ng1, b1 * rs1 * ng1);
        }
    }
    WG_SYNC();
    const int fr = lane & 15, fq = lane >> 4;
    f32x4 acc[8];
#pragma unroll
    for (int ct = 0; ct < 8; ++ct) acc[ct] = (f32x4){0.f, 0.f, 0.f, 0.f};
    const float* wrow = wsp + ((size_t)g * 128 + 16 * wave + fr) * 128 + 8 * fq;
    f32x4 wa[8];
#pragma unroll
    for (int ks = 0; ks < 4; ++ks) { wa[2 * ks] = *(const f32x4*)(wrow + 32 * ks); wa[2 * ks + 1] = *(const f32x4*)(wrow + 32 * ks + 4); }
#pragma unroll
    for (int ks = 0; ks < 4; ++ks) {
        v4u aw; aw.x = pk2(wa[2 * ks].x, wa[2 * ks].y); aw.y = pk2(wa[2 * ks].z, wa[2 * ks].w); aw.z = pk2(wa[2 * ks + 1].x, wa[2 * ks + 1].y); aw.w = pk2(wa[2 * ks + 1].z, wa[2 * ks + 1].w);
        const bf16x8 af = __builtin_bit_cast(bf16x8, aw);
#pragma unroll
        for (int ct = 0; ct < 8; ++ct) {
            const bf16x8 bfr = *(const LAS bf16x8*)(lds + (16 * ct + fr) * VROW + (32 * ks + 8 * fq) * 2);
            acc[ct] = __builtin_amdgcn_mfma_f32_16x16x32_bf16(af, bfr, acc[ct], 0, 0, 0);
        }
    }
#pragma unroll
    for (int r = 0; r < 4; ++r) {
        const int p = 16 * wave + 4 * fq + r; const float bias = bs[g * 128 + p];
        const float* zu = z + (size_t)(tok0 + p) * ZLD + g * 128; bf16* op = o + (size_t)(tok0 + p) * DM + g * 128;
#pragma unroll
        for (int ct = 0; ct < 8; ++ct) { const int c = 16 * ct + fr; st_bf16(op + c, gelu_tanh(zu[c]) * (acc[ct][r] + bias)); }
    }
    WG_SYNC();
}

struct RwkvW { const float *mu, *w0, *w2, *a0, *a2, *g2, *kkw, *kaw, *rk; };
__device__ __forceinline__ void rwkv_prep_item(const float* z, const RwkvW P, unsigned char* ws, LAS unsigned char* lds, int item, int tid, int lane) {
    LAS float* zm = (LAS float*)lds;
    LAS float* xl = (LAS float*)(lds + 73728);
    float* R = (float*)(ws + WS_R); float* V = (float*)(ws + WS_V); float* KK = (float*)(ws + WS_KK); float* GATE = (float*)(ws + WS_GATE);
    float* W = (float*)(ws + WS_W); float* KD = (float*)(ws + WS_KD); float* Bv = (float*)(ws + WS_BV); float* BON = (float*)(ws + WS_BON);
    const int tok0 = item * 8;
#pragma unroll 1
    for (int th = 0; th < 2; ++th) {
        float cur[4][6], prv[4][6], nxt[4][6];
#pragma unroll
        for (int t4i = 0; t4i < 4; ++t4i) {
            const int m = tok0 + th * 4 + t4i; int t, T;
            if (m < 4096) { t = m & 255; T = 256; } else { t = (m - 4096) & 1023; T = 1024; }
            const float* zc = z + (size_t)m * ZLD + ZB0;
            const bool hp = t > 0, hn = t < T - 1;
#pragma unroll
            for (int i = 0; i < 6; ++i) { const int c = tid + 512 * i; const bool ok = c < 2688;
                cur[t4i][i] = ok ? zc[c] : 0.f; prv[t4i][i] = (ok && hp) ? zc[c - ZLD] : 0.f; nxt[t4i][i] = (ok && hn) ? zc[c + ZLD] : 0.f; }
        }
#pragma unroll
        for (int t4i = 0; t4i < 4; ++t4i) {
            const int tt = th * 4 + t4i;
#pragma unroll
            for (int i = 0; i < 6; ++i) {
                const int c = tid + 512 * i;
                if (c < 2688) {
                    float v = cur[t4i][i] + (0.5f * (prv[t4i][i] + nxt[t4i][i]) - cur[t4i][i]) * P.mu[c];
                    if (c < 2304) zm[tt * 2304 + c] = v;
                    else { const int j = c - 2304; if (j < 128) v = tanhf(v); else if (j >= 256) v = sigmoid_f(v); xl[j * 8 + tt] = v; }
                }
            }
        }
    }
    WG_SYNC();
    const int t4 = (tid >> 8) * 4;
    int cb_ = tid & 255; asm volatile("" : "+v"(cb_));
    const int cb = cb_;
    const f32x4 z4 = (f32x4){0.f, 0.f, 0.f, 0.f};
    f32x4 accw[3][2], acca[3][2], accg[3];
#pragma unroll
    for (int j = 0; j < 3; ++j) { accw[j][0] = accw[j][1] = acca[j][0] = acca[j][1] = accg[j] = z4; }
    {
        float wA[24], aA[24];
#pragma unroll 1
        for (int rb = 0; rb < 16; ++rb) {
            const int r0 = rb * 4;
#pragma unroll
            for (int j = 0; j < 3; ++j)
#pragma unroll
                for (int d = 0; d < 2; ++d)
#pragma unroll
                    for (int rr = 0; rr < 4; ++rr) { const size_t o = ((size_t)d * 64 + r0 + rr) * BWD + cb + 256 * j; wA[(j * 2 + d) * 4 + rr] = P.w2[o]; aA[(j * 2 + d) * 4 + rr] = P.a2[o]; }
#pragma unroll
            for (int d = 0; d < 2; ++d)
#pragma unroll
                for (int rr = 0; rr < 4; ++rr) {
                    const f32x4 xw = *(const LAS f32x4*)(xl + (d * 64 + r0 + rr) * 8 + t4), xa = *(const LAS f32x4*)(xl + (128 + d * 64 + r0 + rr) * 8 + t4);
#pragma unroll
                    for (int j = 0; j < 3; ++j) { accw[j][d] += xw * wA[(j * 2 + d) * 4 + rr]; acca[j][d] += xa * aA[(j * 2 + d) * 4 + rr]; }
                }
        }
    }
    {
        float gA[24];
#pragma unroll 1
        for (int rb = 0; rb < 16; ++rb) {
            const int r0 = rb * 8;
#pragma unroll
            for (int j = 0; j < 3; ++j)
#pragma unroll
                for (int rr = 0; rr < 8; ++rr) gA[j * 8 + rr] = P.g2[(size_t)(r0 + rr) * BWD + cb + 256 * j];
#pragma unroll
            for (int rr = 0; rr < 8; ++rr) { const f32x4 xg = *(const LAS f32x4*)(xl + (256 + r0 + rr) * 8 + t4);
#pragma unroll
                for (int j = 0; j < 3; ++j) accg[j] += xg * gA[j * 8 + rr]; }
        }
    }
#pragma unroll
    for (int j = 0; j < 3; ++j) {
        const int c = cb + 256 * j, head = c >> 6;
        const float w0v[2] = {P.w0[c], P.w0[BWD + c]}, a0v[2] = {P.a0[c], P.a0[BWD + c]}; const float kkwv = P.kkw[c], kawv = P.kaw[c], rkv = P.rk[c];
#pragma unroll
        for (int tt = 0; tt < 4; ++tt) {
            const int m = tok0 + t4 + tt;
            const float r_ = zm[(t4 + tt) * 2304 + c], k_ = zm[(t4 + tt) * 2304 + 768 + c], v_ = zm[(t4 + tt) * 2304 + 1536 + c];
            float kkv = k_ * kkwv;
            const float nrm = sqrtf(wave_sum(kkv * kkv));
            kkv = kkv / fmaxf(nrm, 1e-12f);
            float bon = 0.f;
#pragma unroll
            for (int d = 0; d < 2; ++d) {
                const float wraw = w0v[d] + accw[j][d][tt];
                const float dec = __expf(-0.6065306597126334f * sigmoid_f(wraw));
                const float a = sigmoid_f(a0v[d] + acca[j][d][tt]);
                const float kd = k_ * (1.f + (a - 1.f) * kawv);
                const size_t o = ((size_t)d * NTOK + m) * BWD + c;
                W[o] = dec; KD[o] = kd; Bv[o] = kkv * a;
                bon += r_ * kd * rkv;
            }
            bon = wave_sum(bon);
            if (lane == 0) BON[m * 12 + head] = bon;
            const size_t o = (size_t)m * BWD + c;
            R[o] = r_; V[o] = v_; KK[o] = kkv; GATE[o] = accg[j][tt];
        }
    }
    WG_SYNC();
}

__device__ __forceinline__ void hgrn_prep_row(const float* z, const float* hlb, int l, unsigned char* ws, int m, int tid) {
    float* QS = (float*)(ws + WS_QS); float* FG = (float*)(ws + WS_FG);
    const float* zr = z + (size_t)m * ZLD + ZC0;
    for (int c = tid; c < 768; c += 512) {
        QS[(size_t)m * 768 + c] = silu_f(zr[c]);
#pragma unroll
        for (int d = 0; d < 2; ++d) {
            float lbv = 0.f;
            if (l == 1) { const float h0 = hlb[d * 768 + c], h1 = hlb[(2 + d) * 768 + c]; lbv = 1.f / (1.f + __expf(h0 - h1)); }
            FG[((size_t)d * NTOK + m) * 768 + c] = lbv + (1.f - lbv) * sigmoid_f(zr[768 + d * 768 + c]);
        }
    }
}

__device__ __forceinline__ void rwkv_scan_chain(unsigned char* ws, const float* state_in, float* state_out, int l, int chain, int lane) {
    const float* R = (const float*)(ws + WS_R); const float* V = (const float*)(ws + WS_V); const float* KK = (const float*)(ws + WS_KK);
    const float* W = (const float*)(ws + WS_W); const float* KD = (const float*)(ws + WS_KD); const float* Bv = (const float*)(ws + WS_BV); float* Y = (float*)(ws + WS_Y);
    const int dir = chain & 1, head = (chain >> 1) % 12, seq = chain / 24;
    int T, base; float s[64];
    if (seq < 16) {
        T = 256; base = seq * 256;
#pragma unroll
        for (int k = 0; k < 64; ++k) s[k] = 0.f;
    } else {
        const int b = seq - 16; T = 1024; base = 4096 + b * 1024;
        const float* sp = state_in + ((((size_t)(b * 2 + l) * 2 + dir) * 12 + head) * 64 + lane) * 64;
#pragma unroll
        for (int k = 0; k < 64; ++k) s[k] = sp[k];
    }
    for (int step = 0; step < T; ++step) {
        const int t = dir ? T - 1 - step : step, m = base + t;
        const float* rp = R + (size_t)m * BWD + head * 64;
        const float* kkp = KK + (size_t)m * BWD + head * 64;
        const float* wp = W + ((size_t)dir * NTOK + m) * BWD + head * 64;
        const float* kdp = KD + ((size_t)dir * NTOK + m) * BWD + head * 64;
        const float* bp = Bv + ((size_t)dir * NTOK + m) * BWD + head * 64;
        const float vv = V[(size_t)m * BWD + head * 64 + lane];
        float sa = 0.f;
#pragma unroll
        for (int k = 0; k < 64; ++k) sa -= s[k] * kkp[k];
#pragma unroll
        for (int k = 0; k < 64; ++k) s[k] = s[k] * wp[k] + sa * bp[k] + vv * kdp[k];
        float y = 0.f;
#pragma unroll
        for (int k = 0; k < 64; ++k) y += s[k] * rp[k];
        Y[((size_t)dir * NTOK + m) * BWD + head * 64 + lane] = y;
    }
    if (seq < 16) {
        float* sp = state_out + ((((size_t)(seq * 2 + l) * 2 + dir) * 12 + head) * 64 + lane) * 64;
#pragma unroll
        for (int k = 0; k < 64; ++k) sp[k] = s[k];
    }
}
__device__ __forceinline__ void hgrn_scan_half(const float* z, unsigned char* ws, const float* state_in, float* state_out, int l, int item, int lane) {
    const float* QS = (const float*)(ws + WS_QS); const float* FG = (const float*)(ws + WS_FG); float* HO = (float*)(ws + WS_HO);
    const int chain = item >> 1, vcol = (item & 1) * 64 + lane;
    const int dir = chain & 1, head = (chain >> 1) % 6, seq = chain / 12;
    int T, base; float s[128];
    if (seq < 16) {
        T = 256; base = seq * 256;
#pragma unroll
        for (int k = 0; k < 128; ++k) s[k] = 0.f;
    } else {
        const int b = seq - 16; T = 1024; base = 4096 + b * 1024;
        const float* sp = state_in + (((size_t)(b * 2 + l) * 2 + dir) * 6 + head) * 128 * 128 + vcol;
#pragma unroll
        for (int k = 0; k < 128; ++k) s[k] = sp[k * 128];
    }
    for (int step = 0; step < T; ++step) {
        const int t = dir ? T - 1 - step : step, m = base + t;
        const float* qp = QS + (size_t)m * 768 + head * 128;
        const float* fp = FG + ((size_t)dir * NTOK + m) * 768 + head * 128;
        const float vv = z[(size_t)m * ZLD + ZC0 + 2304 + head * 128 + vcol];
        float o = 0.f;
#pragma unroll
        for (int k = 0; k < 128; ++k) { const float f = fp[k]; s[k] = f * s[k] + (1.f - f) * vv; o += s[k] * qp[k]; }
        HO[((size_t)dir * NTOK + m) * 768 + head * 128 + vcol] = o;
    }
    if (seq < 16) {
        float* sp = state_out + (((size_t)(seq * 2 + l) * 2 + dir) * 6 + head) * 128 * 128 + vcol;
#pragma unroll
        for (int k = 0; k < 128; ++k) sp[k * 128] = s[k];
    }
}

__device__ __forceinline__ void rwkv_post_item4(unsigned char* ws, const float* lg, const float* lb, bf16* o, int j, int lane) {
    const float* Y = (const float*)(ws + WS_Y); const float* V = (const float*)(ws + WS_V); const float* GATE = (const float*)(ws + WS_GATE); const float* BON = (const float*)(ws + WS_BON);
    const int m = j / 3, h0 = (j - 3 * m) * 4;
    float y[4], v[4], g[4], bo[4], lgv[4], lbv[4];
#pragma unroll
    for (int q = 0; q < 4; ++q) { const int c = (h0 + q) * 64 + lane; const size_t i = (size_t)m * BWD + c;
        y[q] = Y[i] + Y[(size_t)NTOK * BWD + i]; v[q] = V[i]; g[q] = GATE[i]; bo[q] = BON[m * 12 + h0 + q]; lgv[q] = lg[c]; lbv[q] = lb[c]; }
#pragma unroll
    for (int q = 0; q < 4; ++q) {
        const float mean = wave_sum(y[q]) * (1.f / 64.f);
        const float dv = y[q] - mean;
        const float var = wave_sum(dv * dv) * (1.f / 64.f);
        const float out = dv * rsqrtf(var + 64e-5f) * lgv[q] + lbv[q] + bo[q] * v[q];
        st_bf16(o + (size_t)m * DM + 512 + (h0 + q) * 64 + lane, out * g[q]);
    }
}
__device__ __forceinline__ void hgrn_post_item2(const float* z, unsigned char* ws, const float* gn, bf16* o, int j, int lane) {
    const float* HO = (const float*)(ws + WS_HO);
    const int m = j / 3, h0 = (j - 3 * m) * 2;
    float v0[2], v1[2], g0[2], g1[2];
#pragma unroll
    for (int q = 0; q < 2; ++q) { const size_t i = (size_t)m * 768 + (h0 + q) * 128 + lane; const float* gp = z + (size_t)m * ZLD + ZC0 + 3072 + (h0 + q) * 128;
        v0[q] = HO[i] + HO[(size_t)NTOK * 768 + i]; v1[q] = HO[i + 64] + HO[(size_t)NTOK * 768 + i + 64]; g0[q] = gp[lane]; g1[q] = gp[lane + 64]; }
    const float gn0 = gn[lane], gn1 = gn[lane + 64];
#pragma unroll
    for (int q = 0; q < 2; ++q) {
        const float rstd = rsqrtf(wave_sum(v0[q] * v0[q] + v1[q] * v1[q]) * (1.f / 128.f) + 1e-6f);
        st_bf16(o + (size_t)m * DM + 1280 + (h0 + q) * 128 + lane, v0[q] * rstd * gn0 * silu_f(g0[q]));
        st_bf16(o + (size_t)m * DM + 1280 + (h0 + q) * 128 + lane + 64, v1[q] * rstd * gn1 * silu_f(g1[q]));
    }
}

#define RW_QP(i) " quad_perm:[" #i "," #i "," #i "," #i "] row_mask:0xf bank_mask:0xf bound_ctrl:1"
typedef float f32x2 __attribute__((ext_vector_type(2)));
__device__ __forceinline__ void rw_sa_block(float& sa0, float& sa1, float av, float s0, float s1, float s2, float s3) {
    asm("v_fmac_f32_dpp %0, %2, %3" RW_QP(0) "\n\t"
        "v_fmac_f32_dpp %1, %2, %4" RW_QP(1) "\n\t"
        "v_fmac_f32_dpp %0, %2, %5" RW_QP(2) "\n\t"
        "v_fmac_f32_dpp %1, %2, %6" RW_QP(3)
        : "+v"(sa0), "+v"(sa1) : "v"(av), "v"(s0), "v"(s1), "v"(s2), "v"(s3));
}
__device__ __forceinline__ void rw_upd_block(float& s0, float& s1, float& s2, float& s3, float& y0, float& y1, float wv, float bv, float kdv, float rv, float sa, float vv) {
    asm("v_mul_f32_dpp %0, %6, %0" RW_QP(0) "\n\t"
        "v_mul_f32_dpp %1, %6, %1" RW_QP(1) "\n\t"
        "v_mul_f32_dpp %2, %6, %2" RW_QP(2) "\n\t"
        "v_mul_f32_dpp %3, %6, %3" RW_QP(3) "\n\t"
        "v_fmac_f32_dpp %0, %7, %10" RW_QP(0) "\n\t"
        "v_fmac_f32_dpp %1, %7, %10" RW_QP(1) "\n\t"
        "v_fmac_f32_dpp %2, %7, %10" RW_QP(2) "\n\t"
        "v_fmac_f32_dpp %3, %7, %10" RW_QP(3) "\n\t"
        "v_fmac_f32_dpp %0, %8, %11" RW_QP(0) "\n\t"
        "v_fmac_f32_dpp %1, %8, %11" RW_QP(1) "\n\t"
        "v_fmac_f32_dpp %2, %8, %11" RW_QP(2) "\n\t"
        "v_fmac_f32_dpp %3, %8, %11" RW_QP(3) "\n\t"
        "v_fmac_f32_dpp %4, %9, %0" RW_QP(0) "\n\t"
        "v_fmac_f32_dpp %5, %9, %1" RW_QP(1) "\n\t"
        "v_fmac_f32_dpp %4, %9, %2" RW_QP(2) "\n\t"
        "v_fmac_f32_dpp %5, %9, %3" RW_QP(3)
        : "+v"(s0), "+v"(s1), "+v"(s2), "+v"(s3), "+v"(y0), "+v"(y1) : "v"(wv), "v"(bv), "v"(kdv), "v"(rv), "v"(sa), "v"(vv));
}
__device__ __forceinline__ void rw_sa_block_first(float& sa0, float& sa1, float av, float s0, float s1, float s2, float s3) {
    asm("v_mul_f32_dpp %0, %2, %3" RW_QP(0) "\n\t"
        "v_mul_f32_dpp %1, %2, %4" RW_QP(1) "\n\t"
        "v_fmac_f32_dpp %0, %2, %5" RW_QP(2) "\n\t"
        "v_fmac_f32_dpp %1, %2, %6" RW_QP(3)
        : "=&v"(sa0), "=&v"(sa1) : "v"(av), "v"(s0), "v"(s1), "v"(s2), "v"(s3));
}
__device__ __forceinline__ void rw_upd_block_first(float& s0, float& s1, float& s2, float& s3, float& y0, float& y1, float wv, float bv, float kdv, float rv, float sa, float vv) {
    asm("v_mul_f32_dpp %0, %6, %0" RW_QP(0) "\n\t"
        "v_mul_f32_dpp %1, %6, %1" RW_QP(1) "\n\t"
        "v_mul_f32_dpp %2, %6, %2" RW_QP(2) "\n\t"
        "v_mul_f32_dpp %3, %6, %3" RW_QP(3) "\n\t"
        "v_fmac_f32_dpp %0, %7, %10" RW_QP(0) "\n\t"
        "v_fmac_f32_dpp %1, %7, %10" RW_QP(1) "\n\t"
        "v_fmac_f32_dpp %2, %7, %10" RW_QP(2) "\n\t"
        "v_fmac_f32_dpp %3, %7, %10" RW_QP(3) "\n\t"
        "v_fmac_f32_dpp %0, %8, %11" RW_QP(0) "\n\t"
        "v_fmac_f32_dpp %1, %8, %11" RW_QP(1) "\n\t"
        "v_fmac_f32_dpp %2, %8, %11" RW_QP(2) "\n\t"
        "v_fmac_f32_dpp %3, %8, %11" RW_QP(3) "\n\t"
        "v_mul_f32_dpp %4, %9, %0" RW_QP(0) "\n\t"
        "v_mul_f32_dpp %5, %9, %1" RW_QP(1) "\n\t"
        "v_fmac_f32_dpp %4, %9, %2" RW_QP(2) "\n\t"
        "v_fmac_f32_dpp %5, %9, %3" RW_QP(3)
        : "+v"(s0), "+v"(s1), "+v"(s2), "+v"(s3), "=&v"(y0), "=&v"(y1) : "v"(wv), "v"(bv), "v"(kdv), "v"(rv), "v"(sa), "v"(vv));
}
__device__ __forceinline__ float rw_xsum32(float x) { const unsigned u = __builtin_bit_cast(unsigned, x); auto r = __builtin_amdgcn_permlane32_swap(u, u, false, false); return __builtin_bit_cast(float, (unsigned)r[0]) + __builtin_bit_cast(float, (unsigned)r[1]); }
__device__ __forceinline__ float rw_xsum16(float x) { const unsigned u = __builtin_bit_cast(unsigned, x); auto r = __builtin_amdgcn_permlane16_swap(u, u, false, false); return __builtin_bit_cast(float, (unsigned)r[0]) + __builtin_bit_cast(float, (unsigned)r[1]); }
__device__ __forceinline__ float rw_xsum8(float x) { return x + __builtin_bit_cast(float, __builtin_amdgcn_update_dpp(0, __builtin_bit_cast(int, x), 0x128  , 0xf, 0xf, false)); }
__device__ __forceinline__ float rw_xsum4(float x) { return x + __builtin_bit_cast(float, __builtin_amdgcn_update_dpp(0, __builtin_bit_cast(int, x), 0x124  , 0xf, 0xf, false)); }
template <int KS> __device__ __forceinline__ float rw_kseg_sum(float x) {
    if (KS >= 8) x = rw_xsum8(x);
    if (KS >= 16) x = rw_xsum4(x);
    if (KS >= 4) x = rw_xsum16(x);
    if (KS >= 2) x = rw_xsum32(x);
    return x;
}

template <int NM> __device__ __forceinline__ void rw_ldv(float (&d)[NM], const LAS unsigned char* p) {
    if constexpr (NM == 1) { d[0] = *(const LAS float*)p; }
    else if constexpr (NM == 2) { const f32x2 v = *(const LAS f32x2*)p; d[0] = v.x; d[1] = v.y; }
    else {
#pragma unroll
        for (int m = 0; m < NM; m += 4) { const f32x4 v = *(const LAS f32x4*)(p + m * 4); d[m] = v.x; d[m + 1] = v.y; d[m + 2] = v.z; d[m + 3] = v.w; }
    }
}
template <int N> __device__ __forceinline__ void rw_wait_vm() { asm volatile("s_waitcnt vmcnt(%0) lgkmcnt(0)" :: "n"(N) : "memory"); }
template <int D> __device__ __forceinline__ void rw_ring_wait(int ti, int ntiles) {
#ifdef MK_E1
    rw_wait_vm<0>(); return;
#endif
    const int rem = ntiles - 1 - ti;
    if (ti <= D) rw_wait_vm<6 * (D - 1)>();
    else if (rem >= D - 1) rw_wait_vm<4 * D + 6 * (D - 1)>();
    else if (D >= 3 && rem == 1) rw_wait_vm<4 * D + 6>();
    else rw_wait_vm<4 * D>();
}
template <int KS, int NB>
__device__ __forceinline__ void rwkv_scan_wave(unsigned char* ws, const float* state_in, float* state_out, int l, int chain, int rowblk, LAS unsigned char* wlds, int lane) {
    constexpr int RW = 64 / KS, KL = 64 / KS, NM = KL / 4, TS = 4;
    constexpr int TILE_BYTES = 6 * TS * 256;
    const int rowbase = rowblk * RW;
    const int j = lane & 3, q = lane >> 2, rq = q % (RW / 4), kseg = q / (RW / 4), row = rowbase + 4 * rq + j;
    const int dir = chain & 1, head = (chain >> 1) % 12, seq = chain / 24;
    const int T = seq < 16 ? 256 : 1024, base = seq < 16 ? seq * 256 : 4096 + (seq - 16) * 1024;
    float* Y = (float*)(ws + WS_Y);
    float s[KL];
    if (seq < 16) {
#pragma unroll
        for (int k = 0; k < KL; ++k) s[k] = 0.f;
    } else {
        const float* sp = state_in + (((((size_t)(seq - 16) * 2 + l) * 2 + dir) * 12 + head) * 64 + row) * 64 + kseg * KL;
#pragma unroll
        for (int k = 0; k < KL; k += 4) { const f32x4 v = *(const f32x4*)(sp + k); s[k] = v.x; s[k + 1] = v.y; s[k + 2] = v.z; s[k + 3] = v.w; }
    }
    const int ntiles = T / TS;
    const int tstep = dir ? -TS * BWD * 4 : TS * BWD * 4;
    unsigned vnext;
    { const int st = lane >> 4, tok0 = dir ? T - 1 - st : st; vnext = (unsigned)(((base + tok0) * BWD + head * 64) * 4 + (lane & 15) * 16); }
    const size_t abase[6] = {WS_W + (size_t)dir * SZ_T, WS_KD + (size_t)dir * SZ_T, WS_BV + (size_t)dir * SZ_T, WS_KK, WS_R, WS_V};
#define RW_ISSUE(ti, bufoff) do { _Pragma("unroll") for (int _a = 0; _a < 6; ++_a) \
        __builtin_amdgcn_global_load_lds((const unsigned*)((const char*)ws + abase[_a] + (size_t)vnext), (LAS unsigned*)(wlds + (bufoff) + _a * TS * 256), 16, 0, 0); vnext += (unsigned)tstep; } while (0)
    constexpr int D = NB - 1;
#pragma unroll
    for (int d = 0; d < D; ++d) RW_ISSUE(d, d * TILE_BYTES);
    const unsigned opoff = (unsigned)((kseg * KL + j * NM) * 4), voffv = (unsigned)(5 * TS * 256 + row * 4);
    float ybuf[TS];
    float* yq = Y + ((size_t)dir * NTOK + base + (dir ? T - 1 : 0)) * BWD + head * 64 + row;
    const long ys = dir ? -(long)BWD : (long)BWD;
    int cur = 0, nxt = D;
    for (int ti = 0; ti < ntiles; ++ti) {
        rw_ring_wait<D>(ti, ntiles);
        if (ti + D < ntiles) RW_ISSUE(ti + D, nxt * TILE_BYTES);
        if (ti > 0) {
            if (kseg == 0) { yq[0] = ybuf[0]; yq[ys] = ybuf[1]; yq[2 * ys] = ybuf[2]; yq[3 * ys] = ybuf[3]; }
            yq += 4 * ys;
        }
        const LAS unsigned char* tb = wlds + cur * TILE_BYTES;
        cur = cur + 1 == NB ? 0 : cur + 1; nxt = nxt + 1 == NB ? 0 : nxt + 1;
        float wv[2][NM], kdv[2][NM], bv[2][NM], kkv[2][NM], rv[2][NM], vv[2];
#define RW_LOADOPS(bi, st_) do { rw_ldv<NM>(wv[bi], tb + opoff + (0 * TS + (st_)) * 256); rw_ldv<NM>(kdv[bi], tb + opoff + (1 * TS + (st_)) * 256); rw_ldv<NM>(bv[bi], tb + opoff + (2 * TS + (st_)) * 256); \
            rw_ldv<NM>(kkv[bi], tb + opoff + (3 * TS + (st_)) * 256); rw_ldv<NM>(rv[bi], tb + opoff + (4 * TS + (st_)) * 256); vv[bi] = *(const LAS float*)(tb + voffv + (st_) * 256); } while (0)
        RW_LOADOPS(0, 0);
#pragma unroll
        for (int st = 0; st < TS; ++st) {
            constexpr int dummy = 0; (void)dummy;
            const int cb = st & 1, nb = cb ^ 1;
            if (st + 1 < TS) RW_LOADOPS(nb, st + 1);
            __builtin_amdgcn_sched_barrier(0);
            float sa0, sa1;
            rw_sa_block_first(sa0, sa1, kkv[cb][0], s[0], s[NM], s[2 * NM], s[3 * NM]);
#pragma unroll
            for (int m = 1; m < NM; ++m) rw_sa_block(sa0, sa1, kkv[cb][m], s[m], s[NM + m], s[2 * NM + m], s[3 * NM + m]);
            const float sa = rw_kseg_sum<KS>(-sa0 - sa1);
            float y0, y1;
            rw_upd_block_first(s[0], s[NM], s[2 * NM], s[3 * NM], y0, y1, wv[cb][0], bv[cb][0], kdv[cb][0], rv[cb][0], sa, vv[cb]);
#pragma unroll
            for (int m = 1; m < NM; ++m) rw_upd_block(s[m], s[NM + m], s[2 * NM + m], s[3 * NM + m], y0, y1, wv[cb][m], bv[cb][m], kdv[cb][m], rv[cb][m], sa, vv[cb]);
            ybuf[st] = y0 + y1;
        }
#undef RW_LOADOPS
        if (KS >= 8) {
#pragma unroll
            for (int st = 0; st < TS; ++st) ybuf[st] = rw_xsum8(ybuf[st]);
        }
        if (KS >= 16) {
#pragma unroll
            for (int st = 0; st < TS; ++st) ybuf[st] = rw_xsum4(ybuf[st]);
        }
        if (KS >= 4) {
#pragma unroll
            for (int st = 0; st < TS; ++st) ybuf[st] = rw_xsum16(ybuf[st]);
        }
#pragma unroll
        for (int st = 0; st < TS; ++st) ybuf[st] = rw_xsum32(ybuf[st]);
    }
    if (kseg == 0) {
        yq[0] = ybuf[0]; yq[ys] = ybuf[1]; yq[2 * ys] = ybuf[2]; yq[3 * ys] = ybuf[3];
    }
#undef RW_ISSUE
    if (seq < 16) {
        float* sp = state_out + (((((size_t)seq * 2 + l) * 2 + dir) * 12 + head) * 64 + row) * 64 + kseg * KL;
#pragma unroll
        for (int k = 0; k < KL; k += 4) *(f32x4*)(sp + k) = (f32x4){s[k], s[k + 1], s[k + 2], s[k + 3]};
    }
    asm volatile("s_waitcnt vmcnt(0) lgkmcnt(0)" ::: "memory");
}

#define RQ_P0 " quad_perm:[0,0,2,2] row_mask:0xf bank_mask:0xf bound_ctrl:1"
#define RQ_P1 " quad_perm:[1,1,3,3] row_mask:0xf bank_mask:0xf bound_ctrl:1"
__device__ __forceinline__ void rq_sa_all(float& a0, float& a1, float& a2, float& a3, const float (&kk)[4], const float (&s)[8]) {
    asm("v_fmac_f32_dpp %0, %4, %8" RQ_P0 "\n\t" "v_fmac_f32_dpp %1, %5, %9" RQ_P0 "\n\t" "v_fmac_f32_dpp %2, %6, %10" RQ_P0 "\n\t" "v_fmac_f32_dpp %3, %7, %11" RQ_P0 "\n\t"
        "v_fmac_f32_dpp %0, %4, %12" RQ_P1 "\n\t" "v_fmac_f32_dpp %1, %5, %13" RQ_P1 "\n\t" "v_fmac_f32_dpp %2, %6, %14" RQ_P1 "\n\t" "v_fmac_f32_dpp %3, %7, %15" RQ_P1
        : "+v"(a0), "+v"(a1), "+v"(a2), "+v"(a3) : "v"(kk[0]), "v"(kk[1]), "v"(kk[2]), "v"(kk[3]), "v"(s[0]), "v"(s[1]), "v"(s[2]), "v"(s[3]), "v"(s[4]), "v"(s[5]), "v"(s[6]), "v"(s[7]));
}
__device__ __forceinline__ void rq_upd_all(float (&s)[8], float& y0, float& y1, const float (&w)[4], const float (&b)[4], const float (&kd)[4], const float (&r)[4], float sa, float vv) {
    asm("v_mul_f32_dpp %0, %10, %0" RQ_P0 "\n\t" "v_mul_f32_dpp %1, %11, %1" RQ_P0 "\n\t" "v_mul_f32_dpp %2, %12, %2" RQ_P0 "\n\t" "v_mul_f32_dpp %3, %13, %3" RQ_P0 "\n\t"
        "v_mul_f32_dpp %4, %10, %4" RQ_P1 "\n\t" "v_mul_f32_dpp %5, %11, %5" RQ_P1 "\n\t" "v_mul_f32_dpp %6, %12, %6" RQ_P1 "\n\t" "v_mul_f32_dpp %7, %13, %7" RQ_P1 "\n\t"
        "v_fmac_f32_dpp %0, %14, %26" RQ_P0 "\n\t" "v_fmac_f32_dpp %1, %15, %26" RQ_P0 "\n\t" "v_fmac_f32_dpp %2, %16, %26" RQ_P0 "\n\t" "v_fmac_f32_dpp %3, %17, %26" RQ_P0 "\n\t"
        "v_fmac_f32_dpp %4, %14, %26" RQ_P1 "\n\t" "v_fmac_f32_dpp %5, %15, %26" RQ_P1 "\n\t" "v_fmac_f32_dpp %6, %16, %26" RQ_P1 "\n\t" "v_fmac_f32_dpp %7, %17, %26" RQ_P1 "\n\t"
        "v_fmac_f32_dpp %0, %18, %27" RQ_P0 "\n\t" "v_fmac_f32_dpp %1, %19, %27" RQ_P0 "\n\t" "v_fmac_f32_dpp %2, %20, %27" RQ_P0 "\n\t" "v_fmac_f32_dpp %3, %21, %27" RQ_P0 "\n\t"
        "v_fmac_f32_dpp %4, %18, %27" RQ_P1 "\n\t" "v_fmac_f32_dpp %5, %19, %27" RQ_P1 "\n\t" "v_fmac_f32_dpp %6, %20, %27" RQ_P1 "\n\t" "v_fmac_f32_dpp %7, %21, %27" RQ_P1 "\n\t"
        "v_fmac_f32_dpp %8, %22, %0" RQ_P0 "\n\t" "v_fmac_f32_dpp %9, %23, %1" RQ_P0 "\n\t" "v_fmac_f32_dpp %8, %24, %2" RQ_P0 "\n\t" "v_fmac_f32_dpp %9, %25, %3" RQ_P0 "\n\t"
        "v_fmac_f32_dpp %8, %22, %4" RQ_P1 "\n\t" "v_fmac_f32_dpp %9, %23, %5" RQ_P1 "\n\t" "v_fmac_f32_dpp %8, %24, %6" RQ_P1 "\n\t" "v_fmac_f32_dpp %9, %25, %7" RQ_P1
        : "+v"(s[0]), "+v"(s[1]), "+v"(s[2]), "+v"(s[3]), "+v"(s[4]), "+v"(s[5]), "+v"(s[6]), "+v"(s[7]), "+v"(y0), "+v"(y1)
        : "v"(w[0]), "v"(w[1]), "v"(w[2]), "v"(w[3]), "v"(b[0]), "v"(b[1]), "v"(b[2]), "v"(b[3]), "v"(kd[0]), "v"(kd[1]), "v"(kd[2]), "v"(kd[3]), "v"(r[0]), "v"(r[1]), "v"(r[2]), "v"(r[3]), "v"(sa), "v"(vv));
}
#define RQ_SWP " quad_perm:[2,3,0,1] row_mask:0xf bank_mask:0xf"
__device__ __forceinline__ float rq_sum(float x) {
    float r;
    asm("s_nop 1\n\tv_add_f32_dpp %0, %1, %1" RQ_SWP "\n\ts_nop 1\n\tv_add_f32_dpp %0, %0, %0 row_ror:8 row_mask:0xf bank_mask:0xf\n\ts_nop 1\n\tv_add_f32_dpp %0, %0, %0 row_ror:4 row_mask:0xf bank_mask:0xf"
        : "=&v"(r) : "v"(x));
    return r;
}
__device__ __forceinline__ void rq_sum4(float (&y)[4]) {
    asm("s_nop 1\n\t"
        "v_add_f32_dpp %0, %0, %0" RQ_SWP "\n\t" "v_add_f32_dpp %1, %1, %1" RQ_SWP "\n\t" "v_add_f32_dpp %2, %2, %2" RQ_SWP "\n\t" "v_add_f32_dpp %3, %3, %3" RQ_SWP "\n\t"
        "v_add_f32_dpp %0, %0, %0 row_ror:8 row_mask:0xf bank_mask:0xf\n\t" "v_add_f32_dpp %1, %1, %1 row_ror:8 row_mask:0xf bank_mask:0xf\n\t"
        "v_add_f32_dpp %2, %2, %2 row_ror:8 row_mask:0xf bank_mask:0xf\n\t" "v_add_f32_dpp %3, %3, %3 row_ror:8 row_mask:0xf bank_mask:0xf\n\t"
        "v_add_f32_dpp %0, %0, %0 row_ror:4 row_mask:0xf bank_mask:0xf\n\t" "v_add_f32_dpp %1, %1, %1 row_ror:4 row_mask:0xf bank_mask:0xf\n\t"
        "v_add_f32_dpp %2, %2, %2 row_ror:4 row_mask:0xf bank_mask:0xf\n\t" "v_add_f32_dpp %3, %3, %3 row_ror:4 row_mask:0xf bank_mask:0xf"
        : "+v"(y[0]), "+v"(y[1]), "+v"(y[2]), "+v"(y[3]));
}
template <int NB>
__device__ __forceinline__ void rwkv_scan_wave_l8(unsigned char* ws, const float* state_in, float* state_out, int l, int chain, int rowblk, LAS unsigned char* wlds, int lane) {
    constexpr int KL = 8, TS = 4, TILE_BYTES = 6 * TS * 256;
    const int jr = lane & 1, kseg = ((lane >> 2) & 3) * 2 + ((lane >> 1) & 1), row = rowblk * 8 + 2 * (lane >> 4) + jr;
    const int dir = chain & 1, head = (chain >> 1) % 12, seq = chain / 24;
    const int T = seq < 16 ? 256 : 1024, base = seq < 16 ? seq * 256 : 4096 + (seq - 16) * 1024;
    float* Y = (float*)(ws + WS_Y);
    float s[KL];
    if (seq < 16) {
#pragma unroll
        for (int k = 0; k < KL; ++k) s[k] = 0.f;
    } else {
        const float* sp = state_in + (((((size_t)(seq - 16) * 2 + l) * 2 + dir) * 12 + head) * 64 + row) * 64 + kseg * KL;
        const f32x4 v0 = *(const f32x4*)sp, v1 = *(const f32x4*)(sp + 4);
        s[0] = v0.x; s[1] = v0.y; s[2] = v0.z; s[3] = v0.w; s[4] = v1.x; s[5] = v1.y; s[6] = v1.z; s[7] = v1.w;
    }
    const int ntiles = T / TS;
    const int tstep = dir ? -TS * BWD * 4 : TS * BWD * 4;
    long voff;
    { const int st = lane >> 4, tok0 = dir ? T - 1 - st : st; voff = ((long)(base + tok0) * BWD + head * 64) * 4 + (lane & 15) * 16; }
    const size_t abase[6] = {WS_W + (size_t)dir * SZ_T, WS_KD + (size_t)dir * SZ_T, WS_BV + (size_t)dir * SZ_T, WS_KK, WS_R, WS_V};
#ifdef MK_E1
#define RQ_ISSUE(ti, bufoff) do { _Pragma("unroll") for (int _a = 0; _a < 12; ++_a) \
        __builtin_amdgcn_global_load_lds((const unsigned*)((const char*)ws + abase[_a % 6] + voff + (long)(ti) * tstep), (LAS unsigned*)(wlds + (bufoff) + (_a % 6) * TS * 256), 16, 0, 0); } while (0)
#else
#define RQ_ISSUE(ti, bufoff) do { _Pragma("unroll") for (int _a = 0; _a < 6; ++_a) \
        __builtin_amdgcn_global_load_lds((const unsigned*)((const char*)ws + abase[_a] + voff + (long)(ti) * tstep), (LAS unsigned*)(wlds + (bufoff) + _a * TS * 256), 16, 0, 0); } while (0)
#endif
    constexpr int D = NB - 1;
#pragma unroll
    for (int d = 0; d < D; ++d) RQ_ISSUE(d, d * TILE_BYTES);
    const unsigned opoff = (unsigned)((kseg * KL + jr * 4) * 4), voffv = (unsigned)(5 * TS * 256 + row * 4);
    const bool wr = (lane & 0xE) == 0;
    float ybuf[TS];
    int cur = 0, nxt = D;
    for (int ti = 0; ti < ntiles; ++ti) {
        rw_ring_wait<D>(ti, ntiles);
        if (ti + D < ntiles) RQ_ISSUE(ti + D, nxt * TILE_BYTES);
        if (ti > 0 && wr) {
#pragma unroll
            for (int st = 0; st < TS; ++st) { const int sg = (ti - 1) * TS + st, t = dir ? T - 1 - sg : sg; Y[((size_t)dir * NTOK + base + t) * BWD + head * 64 + row] = ybuf[st]; }
        }
        const LAS unsigned char* tb = wlds + cur * TILE_BYTES;
        cur = cur + 1 == NB ? 0 : cur + 1; nxt = nxt + 1 == NB ? 0 : nxt + 1;
        float wv[2][4], kdv[2][4], bv[2][4], kkv[2][4], rv[2][4], vv[2];
#define RQ_LOADOPS(bi, st_) do { rw_ldv<4>(wv[bi], tb + opoff + (0 * TS + (st_)) * 256); rw_ldv<4>(kdv[bi], tb + opoff + (1 * TS + (st_)) * 256); rw_ldv<4>(bv[bi], tb + opoff + (2 * TS + (st_)) * 256); \
            rw_ldv<4>(kkv[bi], tb + opoff + (3 * TS + (st_)) * 256); rw_ldv<4>(rv[bi], tb + opoff + (4 * TS + (st_)) * 256); vv[bi] = *(const LAS float*)(tb + voffv + (st_) * 256); } while (0)
        RQ_LOADOPS(0, 0);
#pragma unroll
        for (int st = 0; st < TS; ++st) {
            const int cb = st & 1, nb = cb ^ 1;
            if (st + 1 < TS) RQ_LOADOPS(nb, st + 1);
            __builtin_amdgcn_sched_barrier(0);
            float a0 = 0.f, a1 = 0.f, a2 = 0.f, a3 = 0.f;
            rq_sa_all(a0, a1, a2, a3, kkv[cb], s);
            const float sa = -rq_sum((a0 + a1) + (a2 + a3));
            float y0 = 0.f, y1 = 0.f;
            rq_upd_all(s, y0, y1, wv[cb], bv[cb], kdv[cb], rv[cb], sa, vv[cb]);
#ifdef MK_E2
            asm volatile("v_nop\n v_nop\n v_nop\n v_nop\n v_nop\n v_nop\n v_nop\n v_nop\n v_nop\n v_nop\n v_nop\n v_nop\n v_nop\n v_nop\n v_nop\n v_nop\n" ::: "memory");
#endif
            ybuf[st] = y0 + y1;
        }
#undef RQ_LOADOPS
        rq_sum4(ybuf);
    }
#undef RQ_ISSUE
    if (wr) {
#pragma unroll
        for (int st = 0; st < TS; ++st) { const int sg = (ntiles - 1) * TS + st, t = dir ? T - 1 - sg : sg; Y[((size_t)dir * NTOK + base + t) * BWD + head * 64 + row] = ybuf[st]; }
    }
    if (seq < 16) {
        float* sp = state_out + (((((size_t)seq * 2 + l) * 2 + dir) * 12 + head) * 64 + row) * 64 + kseg * KL;
        *(f32x4*)sp = (f32x4){s[0], s[1], s[2], s[3]}; *(f32x4*)(sp + 4) = (f32x4){s[4], s[5], s[6], s[7]};
    }
    asm volatile("s_waitcnt vmcnt(0) lgkmcnt(0)" ::: "memory");
}

template <int N> struct RwWaitTail { static __device__ __forceinline__ void run(int rem) { if (rem >= N) rw_wait_vm<N>(); else RwWaitTail<N - 1>::run(rem); } };
template <> struct RwWaitTail<0> { static __device__ __forceinline__ void run(int) { rw_wait_vm<0>(); } };

__device__ __forceinline__ void rc_step(f32x2& s01, f32x2& s23, float& y, f32x2 w01, f32x2 w23, f32x2 kd01, f32x2 kd23, f32x2 b01, f32x2 b23, f32x2 kk01, f32x2 kk23, f32x2 r01, f32x2 r23, f32x2 vvp) {
    asm volatile(
        "v_pk_mul_f32 v[252:253], %9, %0\n"
        "v_pk_fma_f32 v[252:253], %10, %1, v[252:253]\n"
        "v_pk_mul_f32 %0, %3, %0\n"
        "v_sub_f32_e64 v254, -v252, v253\n"
        "v_pk_mul_f32 %1, %4, %1\n"
        "v_pk_fma_f32 %0, %5, %13, %0 op_sel_hi:[1,0,1]\n"
        "v_add_f32_dpp v254, v254, v254 quad_perm:[1,0,3,2] row_mask:0xf bank_mask:0xf\n"
        "v_pk_fma_f32 %1, %6, %13, %1 op_sel_hi:[1,0,1]\n"
        "s_nop 0\n"
        "v_add_f32_dpp v254, v254, v254 quad_perm:[2,3,0,1] row_mask:0xf bank_mask:0xf\n"
        "s_nop 1\n"
        "v_add_f32_dpp v254, v254, v254 row_ror:4 row_mask:0xf bank_mask:0xf\n"
        "s_nop 1\n"
        "v_add_f32_dpp v254, v254, v254 row_ror:8 row_mask:0xf bank_mask:0xf\n"
        "v_pk_fma_f32 %0, %7, v[254:255], %0 op_sel_hi:[1,0,1]\n"
        "v_pk_fma_f32 %1, %8, v[254:255], %1 op_sel_hi:[1,0,1]\n"
        "v_pk_mul_f32 v[252:253], %11, %0\n"
        "v_pk_fma_f32 v[252:253], %12, %1, v[252:253]\n"
        "v_add_f32_e32 %2, v252, v253\n"
        : "+v"(s01), "+v"(s23), "=&v"(y)
        : "v"(w01), "v"(w23), "v"(kd01), "v"(kd23), "v"(b01), "v"(b23), "v"(kk01), "v"(kk23), "v"(r01), "v"(r23), "v"(vvp)
        : "v252", "v253", "v254", "v255");
}
__device__ __forceinline__ void rc_rowsum4(float (&y)[4]) {
    asm volatile(
        "s_nop 1\n"
        "v_add_f32_dpp %0, %0, %0 quad_perm:[1,0,3,2] row_mask:0xf bank_mask:0xf\n v_add_f32_dpp %1, %1, %1 quad_perm:[1,0,3,2] row_mask:0xf bank_mask:0xf\n"
        "v_add_f32_dpp %2, %2, %2 quad_perm:[1,0,3,2] row_mask:0xf bank_mask:0xf\n v_add_f32_dpp %3, %3, %3 quad_perm:[1,0,3,2] row_mask:0xf bank_mask:0xf\n"
        "v_add_f32_dpp %0, %0, %0 quad_perm:[2,3,0,1] row_mask:0xf bank_mask:0xf\n v_add_f32_dpp %1, %1, %1 quad_perm:[2,3,0,1] row_mask:0xf bank_mask:0xf\n"
        "v_add_f32_dpp %2, %2, %2 quad_perm:[2,3,0,1] row_mask:0xf bank_mask:0xf\n v_add_f32_dpp %3, %3, %3 quad_perm:[2,3,0,1] row_mask:0xf bank_mask:0xf\n"
        "v_add_f32_dpp %0, %0, %0 row_ror:4 row_mask:0xf bank_mask:0xf\n v_add_f32_dpp %1, %1, %1 row_ror:4 row_mask:0xf bank_mask:0xf\n"
        "v_add_f32_dpp %2, %2, %2 row_ror:4 row_mask:0xf bank_mask:0xf\n v_add_f32_dpp %3, %3, %3 row_ror:4 row_mask:0xf bank_mask:0xf\n"
        "v_add_f32_dpp %0, %0, %0 row_ror:8 row_mask:0xf bank_mask:0xf\n v_add_f32_dpp %1, %1, %1 row_ror:8 row_mask:0xf bank_mask:0xf\n"
        "v_add_f32_dpp %2, %2, %2 row_ror:8 row_mask:0xf bank_mask:0xf\n v_add_f32_dpp %3, %3, %3 row_ror:8 row_mask:0xf bank_mask:0xf\n"
        : "+v"(y[0]), "+v"(y[1]), "+v"(y[2]), "+v"(y[3]));
}

__device__ __forceinline__ void rwkv_scan_coop(unsigned char* ws, const float* state_in, float* state_out, int l, int chain, int hb, LAS unsigned char* lds, int wave, int lane) {
    constexpr int TS = 4, TILE_BYTES = 6 * TS * 256, NB = 12, D = NB - 1;
    const int dir = chain & 1, head = (chain >> 1) % 12, seq = chain / 24;
    const int T = seq < 16 ? 256 : 1024, base = seq < 16 ? seq * 256 : 4096 + (seq - 16) * 1024, ntiles = T / TS;
    const int kseg = lane & 15, row = (hb * 8 + wave) * 4 + (lane >> 4);
    f32x2 s01 = {0.f, 0.f}, s23 = {0.f, 0.f};
    if (seq >= 16) {
        const float* sp = state_in + (((((size_t)(seq - 16) * 2 + l) * 2 + dir) * 12 + head) * 64 + row) * 64 + kseg * 4;
        const f32x4 v = *(const f32x4*)sp; s01 = (f32x2){v.x, v.y}; s23 = (f32x2){v.z, v.w};
    }
    const bool issuer = wave < 6;
    const size_t ab = wave == 0 ? WS_W + (size_t)dir * SZ_T : wave == 1 ? WS_KD + (size_t)dir * SZ_T : wave == 2 ? WS_BV + (size_t)dir * SZ_T : wave == 3 ? WS_KK : wave == 4 ? WS_R : WS_V;
    const int tstep = dir ? -TS * BWD * 4 : TS * BWD * 4;
    const char* src;
    { const int st = lane >> 4, tok0 = dir ? T - 1 - st : st; src = (const char*)ws + ab + ((long)(base + tok0) * BWD + head * 64) * 4 + (lane & 15) * 16; }
    LAS unsigned char* dstp = lds + (wave < 6 ? wave : 0) * TS * 256;
    asm volatile("s_waitcnt vmcnt(0) lgkmcnt(0)" ::: "memory");
    __builtin_amdgcn_s_barrier();
    if (issuer) {
#pragma unroll
        for (int d = 0; d < D; ++d) __builtin_amdgcn_global_load_lds((const unsigned*)(src + (long)d * tstep), (LAS unsigned*)(dstp + d * TILE_BYTES), 16, 0, 0);
    }
    float* yp = (float*)(ws + WS_Y) + ((size_t)dir * NTOK + base + (dir ? T - 1 - (kseg & 3) : (kseg & 3))) * BWD + head * 64 + row;
    const long ystep = dir ? -(long)TS * BWD : (long)TS * BWD;
    const unsigned opoff = (unsigned)(kseg * 16), voffv = (unsigned)(5 * TS * 256 + row * 4);
    int cur = 0, nxt = D;
    for (int ti = 0; ti < ntiles; ++ti) {
        const int rem = ntiles - 1 - ti;
        if (issuer) { if (rem >= D - 1) rw_wait_vm<D - 1>(); else RwWaitTail<D - 2>::run(rem); }
        else asm volatile("s_waitcnt lgkmcnt(0)" ::: "memory");
        __builtin_amdgcn_s_barrier();
        if (issuer && ti + D < ntiles) __builtin_amdgcn_global_load_lds((const unsigned*)(src + (long)(ti + D) * tstep), (LAS unsigned*)(dstp + nxt * TILE_BYTES), 16, 0, 0);
        const LAS unsigned char* tb = lds + cur * TILE_BYTES;
        cur = cur + 1 == NB ? 0 : cur + 1; nxt = nxt + 1 == NB ? 0 : nxt + 1;
        f32x4 wv[2], kdv[2], bv[2], kkv[2], rv[2]; f32x2 vv[2]; float ybuf[TS];
#define RC_LOADOPS(bi, st_) do { wv[bi] = *(const LAS f32x4*)(tb + opoff + (0 * TS + (st_)) * 256); kdv[bi] = *(const LAS f32x4*)(tb + opoff + (1 * TS + (st_)) * 256); bv[bi] = *(const LAS f32x4*)(tb + opoff + (2 * TS + (st_)) * 256); \
            kkv[bi] = *(const LAS f32x4*)(tb + opoff + (3 * TS + (st_)) * 256); rv[bi] = *(const LAS f32x4*)(tb + opoff + (4 * TS + (st_)) * 256); vv[bi].x = *(const LAS float*)(tb + voffv + (st_) * 256); } while (0)
        RC_LOADOPS(0, 0);
#pragma unroll
        for (int st = 0; st < TS; ++st) {
            const int cb = st & 1, nb = cb ^ 1;
            if (st + 1 < TS) RC_LOADOPS(nb, st + 1);
            __builtin_amdgcn_sched_barrier(0);
            rc_step(s01, s23, ybuf[st], (f32x2){wv[cb].x, wv[cb].y}, (f32x2){wv[cb].z, wv[cb].w}, (f32x2){kdv[cb].x, kdv[cb].y}, (f32x2){kdv[cb].z, kdv[cb].w}, (f32x2){bv[cb].x, bv[cb].y}, (f32x2){bv[cb].z, bv[cb].w},
                    (f32x2){kkv[cb].x, kkv[cb].y}, (f32x2){kkv[cb].z, kkv[cb].w}, (f32x2){rv[cb].x, rv[cb].y}, (f32x2){rv[cb].z, rv[cb].w}, vv[cb]);
        }
#undef RC_LOADOPS
        rc_rowsum4(ybuf);
        const float val = kseg == 0 ? ybuf[0] : kseg == 1 ? ybuf[1] : kseg == 2 ? ybuf[2] : ybuf[3];
        if (kseg < 4) *yp = val;
        yp += ystep;
    }
    if (seq < 16) {
        float* sp = state_out + (((((size_t)seq * 2 + l) * 2 + dir) * 12 + head) * 64 + row) * 64 + kseg * 4;
        *(f32x4*)sp = (f32x4){s01.x, s01.y, s23.x, s23.y};
    }
    asm volatile("s_waitcnt vmcnt(0) lgkmcnt(0)" ::: "memory");
}

__device__ __forceinline__ void rc8_step(f32x2& s01, f32x2& s23, f32x2& s45, f32x2& s67, float& y, const f32x4 (&w)[2], const f32x4 (&kd)[2], const f32x4 (&b)[2], const f32x4 (&kk)[2], const f32x4 (&r)[2], f32x2 vvp) {
    asm volatile(
        "v_pk_mul_f32 v[248:249], %17, %0\n"
        "v_pk_mul_f32 v[250:251], %18, %1\n"
        "v_pk_fma_f32 v[248:249], %19, %2, v[248:249]\n"
        "v_pk_fma_f32 v[250:251], %20, %3, v[250:251]\n"
        "v_pk_mul_f32 %0, %5, %0\n"
        "v_pk_add_f32 v[248:249], v[248:249], v[250:251]\n"
        "v_pk_mul_f32 %1, %6, %1\n"
        "v_sub_f32_e64 v254, -v248, v249\n"
        "v_pk_mul_f32 %2, %7, %2\n"
        "v_pk_mul_f32 %3, %8, %3\n"
        "v_add_f32_dpp v254, v254, v254 quad_perm:[1,0,3,2] row_mask:0xf bank_mask:0xf\n"
        "v_pk_fma_f32 %0, %9, %25, %0 op_sel_hi:[1,0,1]\n"
        "v_pk_fma_f32 %1, %10, %25, %1 op_sel_hi:[1,0,1]\n"
        "v_add_f32_dpp v254, v254, v254 quad_perm:[2,3,0,1] row_mask:0xf bank_mask:0xf\n"
        "v_pk_fma_f32 %2, %11, %25, %2 op_sel_hi:[1,0,1]\n"
        "v_pk_fma_f32 %3, %12, %25, %3 op_sel_hi:[1,0,1]\n"
        "v_add_f32_dpp v254, v254, v254 row_half_mirror row_mask:0xf bank_mask:0xf\n"
        "v_pk_fma_f32 %0, %13, v[254:255], %0 op_sel_hi:[1,0,1]\n"
        "v_pk_fma_f32 %1, %14, v[254:255], %1 op_sel_hi:[1,0,1]\n"
        "v_pk_fma_f32 %2, %15, v[254:255], %2 op_sel_hi:[1,0,1]\n"
        "v_pk_fma_f32 %3, %16, v[254:255], %3 op_sel_hi:[1,0,1]\n"
        "v_pk_mul_f32 v[248:249], %21, %0\n"
        "v_pk_mul_f32 v[250:251], %22, %1\n"
        "v_pk_fma_f32 v[248:249], %23, %2, v[248:249]\n"
        "v_pk_fma_f32 v[250:251], %24, %3, v[250:251]\n"
        "v_pk_add_f32 v[248:249], v[248:249], v[250:251]\n"
        "v_add_f32_e32 %4, v248, v249\n"
        : "+v"(s01), "+v"(s23), "+v"(s45), "+v"(s67), "=&v"(y)
        : "v"((f32x2){w[0].x, w[0].y}), "v"((f32x2){w[0].z, w[0].w}), "v"((f32x2){w[1].x, w[1].y}), "v"((f32x2){w[1].z, w[1].w}),
          "v"((f32x2){kd[0].x, kd[0].y}), "v"((f32x2){kd[0].z, kd[0].w}), "v"((f32x2){kd[1].x, kd[1].y}), "v"((f32x2){kd[1].z, kd[1].w}),
          "v"((f32x2){b[0].x, b[0].y}), "v"((f32x2){b[0].z, b[0].w}), "v"((f32x2){b[1].x, b[1].y}), "v"((f32x2){b[1].z, b[1].w}),
          "v"((f32x2){kk[0].x, kk[0].y}), "v"((f32x2){kk[0].z, kk[0].w}), "v"((f32x2){kk[1].x, kk[1].y}), "v"((f32x2){kk[1].z, kk[1].w}),
          "v"((f32x2){r[0].x, r[0].y}), "v"((f32x2){r[0].z, r[0].w}), "v"((f32x2){r[1].x, r[1].y}), "v"((f32x2){r[1].z, r[1].w}), "v"(vvp)
        : "v248", "v249", "v250", "v251", "v254", "v255");
}
__device__ __forceinline__ void rc8_rowsum4(float (&y)[4]) {
    asm volatile(
        "s_nop 1\n"
        "v_add_f32_dpp %0, %0, %0 quad_perm:[1,0,3,2] row_mask:0xf bank_mask:0xf\n v_add_f32_dpp %1, %1, %1 quad_perm:[1,0,3,2] row_mask:0xf bank_mask:0xf\n"
        "v_add_f32_dpp %2, %2, %2 quad_perm:[1,0,3,2] row_mask:0xf bank_mask:0xf\n v_add_f32_dpp %3, %3, %3 quad_perm:[1,0,3,2] row_mask:0xf bank_mask:0xf\n"
        "v_add_f32_dpp %0, %0, %0 quad_perm:[2,3,0,1] row_mask:0xf bank_mask:0xf\n v_add_f32_dpp %1, %1, %1 quad_perm:[2,3,0,1] row_mask:0xf bank_mask:0xf\n"
        "v_add_f32_dpp %2, %2, %2 quad_perm:[2,3,0,1] row_mask:0xf bank_mask:0xf\n v_add_f32_dpp %3, %3, %3 quad_perm:[2,3,0,1] row_mask:0xf bank_mask:0xf\n"
        "v_add_f32_dpp %0, %0, %0 row_half_mirror row_mask:0xf bank_mask:0xf\n v_add_f32_dpp %1, %1, %1 row_half_mirror row_mask:0xf bank_mask:0xf\n"
        "v_add_f32_dpp %2, %2, %2 row_half_mirror row_mask:0xf bank_mask:0xf\n v_add_f32_dpp %3, %3, %3 row_half_mirror row_mask:0xf bank_mask:0xf\n"
        : "+v"(y[0]), "+v"(y[1]), "+v"(y[2]), "+v"(y[3]));
}

__device__ __forceinline__ void rwkv_scan_coop8(unsigned char* ws, const float* state_in, float* state_out, int l, int chain, int hb, LAS unsigned char* lds, int wave, int lane) {
    constexpr int TS = 4, TILE_BYTES = 6 * TS * 256, NB = 12, D = NB - 1;
    const int dir = chain & 1, head = (chain >> 1) % 12, seq = chain / 24;
    const int T = seq < 16 ? 256 : 1024, base = seq < 16 ? seq * 256 : 4096 + (seq - 16) * 1024, ntiles = T / TS;
    const int tstep = dir ? -TS * BWD * 4 : TS * BWD * 4;
    if (wave >= 4) {
        const int k = wave - 4;
        const bool loader = k < 3;
        const size_t ab0 = k == 0 ? WS_W + (size_t)dir * SZ_T : k == 1 ? WS_BV + (size_t)dir * SZ_T : WS_R;
        const size_t ab1 = k == 0 ? WS_KD + (size_t)dir * SZ_T : k == 1 ? WS_KK : WS_V;
        const int st = lane >> 4, tok0 = dir ? T - 1 - st : st;
        const long lo = ((long)(base + tok0) * BWD + head * 64) * 4 + (lane & 15) * 16;
        const char* src0 = (const char*)ws + ab0 + lo; const char* src1 = (const char*)ws + ab1 + lo;
        const int pa = k == 0 ? 0 : k == 1 ? 2 : 4, pb = k == 0 ? 1 : k == 1 ? 3 : 5;
        LAS unsigned char* d0 = lds + pa * TS * 256; LAS unsigned char* d1 = lds + pb * TS * 256;
        asm volatile("s_waitcnt vmcnt(0) lgkmcnt(0)" ::: "memory");
        __builtin_amdgcn_s_barrier();
        if (loader) {
#pragma unroll
            for (int d = 0; d < D; ++d) {
                __builtin_amdgcn_global_load_lds((const unsigned*)(src0 + (long)d * tstep), (LAS unsigned*)(d0 + d * TILE_BYTES), 16, 0, 0);
                __builtin_amdgcn_global_load_lds((const unsigned*)(src1 + (long)d * tstep), (LAS unsigned*)(d1 + d * TILE_BYTES), 16, 0, 0);
            }
        }
        int nxt = D;
        for (int ti = 0; ti < ntiles; ++ti) {
            if (ntiles - 1 - ti >= D - 1) rw_wait_vm<2 * (D - 1)>(); else rw_wait_vm<0>();
            __builtin_amdgcn_s_barrier();
            if (loader && ti + D < ntiles) {
                __builtin_amdgcn_global_load_lds((const unsigned*)(src0 + (long)(ti + D) * tstep), (LAS unsigned*)(d0 + nxt * TILE_BYTES), 16, 0, 0);
                __builtin_amdgcn_global_load_lds((const unsigned*)(src1 + (long)(ti + D) * tstep), (LAS unsigned*)(d1 + nxt * TILE_BYTES), 16, 0, 0);
            }
            nxt = nxt + 1 == NB ? 0 : nxt + 1;
        }
    } else {
        const int kseg = lane & 7, row = (hb * 4 + wave) * 8 + (lane >> 3);
        f32x2 s01 = {0.f, 0.f}, s23 = {0.f, 0.f}, s45 = {0.f, 0.f}, s67 = {0.f, 0.f};
        if (seq >= 16) {
            const float* sp = state_in + (((((size_t)(seq - 16) * 2 + l) * 2 + dir) * 12 + head) * 64 + row) * 64 + kseg * 8;
            const f32x4 v0 = *(const f32x4*)sp, v1 = *(const f32x4*)(sp + 4);
            s01 = (f32x2){v0.x, v0.y}; s23 = (f32x2){v0.z, v0.w}; s45 = (f32x2){v1.x, v1.y}; s67 = (f32x2){v1.z, v1.w};
        }
        float* yp = (float*)(ws + WS_Y) + ((size_t)dir * NTOK + base + (dir ? T - 1 - (kseg & 3) : (kseg & 3))) * BWD + head * 64 + row;
        const long ystep = dir ? -(long)TS * BWD : (long)TS * BWD;
        const unsigned opoff = (unsigned)(kseg * 32), voffv = (unsigned)(5 * TS * 256 + row * 4);
        asm volatile("s_waitcnt vmcnt(0) lgkmcnt(0)" ::: "memory");
        __builtin_amdgcn_s_barrier();
        int cur = 0;
        for (int ti = 0; ti < ntiles; ++ti) {
            asm volatile("s_waitcnt lgkmcnt(0)" ::: "memory");
            __builtin_amdgcn_s_barrier();
            const LAS unsigned char* tb = lds + cur * TILE_BYTES;
            cur = cur + 1 == NB ? 0 : cur + 1;
            f32x4 wv[2][2], kdv[2][2], bv[2][2], kkv[2][2], rv[2][2]; f32x2 vv[2]; float ybuf[TS];
#define RC_LD2(dst, a_, st_) do { dst[0] = *(const LAS f32x4*)(tb + opoff + ((a_) * TS + (st_)) * 256); dst[1] = *(const LAS f32x4*)(tb + opoff + ((a_) * TS + (st_)) * 256 + 16); } while (0)
#define RC_LOADOPS(bi, st_) do { RC_LD2(kkv[bi], 3, st_); RC_LD2(wv[bi], 0, st_); RC_LD2(kdv[bi], 1, st_); RC_LD2(bv[bi], 2, st_); RC_LD2(rv[bi], 4, st_); vv[bi].x = *(const LAS float*)(tb + voffv + (st_) * 256); } while (0)
            RC_LOADOPS(0, 0);
#pragma unroll
            for (int st = 0; st < TS; ++st) {
                const int cb = st & 1, nb = cb ^ 1;
                if (st + 1 < TS) RC_LOADOPS(nb, st + 1);
                __builtin_amdgcn_sched_barrier(0);
                rc8_step(s01, s23, s45, s67, ybuf[st], wv[cb], kdv[cb], bv[cb], kkv[cb], rv[cb], vv[cb]);
#ifdef MK_T1
                asm volatile("v_nop\n v_nop\n v_nop\n v_nop\n v_nop\n v_nop\n v_nop\n v_nop\n v_nop\n v_nop\n v_nop\n v_nop\n v_nop\n v_nop\n v_nop\n v_nop\n" ::: "memory");
#endif
#ifdef MK_T2
                asm volatile("v_pk_mul_f32 v[250:251], v[248:249], v[248:249]\n v_pk_mul_f32 v[250:251], v[248:249], v[248:249]\n v_pk_mul_f32 v[250:251], v[248:249], v[248:249]\n v_pk_mul_f32 v[250:251], v[248:249], v[248:249]\n"
                             "v_pk_mul_f32 v[250:251], v[248:249], v[248:249]\n v_pk_mul_f32 v[250:251], v[248:249], v[248:249]\n v_pk_mul_f32 v[250:251], v[248:249], v[248:249]\n v_pk_mul_f32 v[250:251], v[248:249], v[248:249]\n"
                             "v_pk_mul_f32 v[250:251], v[248:249], v[248:249]\n v_pk_mul_f32 v[250:251], v[248:249], v[248:249]\n v_pk_mul_f32 v[250:251], v[248:249], v[248:249]\n v_pk_mul_f32 v[250:251], v[248:249], v[248:249]\n"
                             "v_pk_mul_f32 v[250:251], v[248:249], v[248:249]\n v_pk_mul_f32 v[250:251], v[248:249], v[248:249]\n v_pk_mul_f32 v[250:251], v[248:249], v[248:249]\n v_pk_mul_f32 v[250:251], v[248:249], v[248:249]\n" ::: "memory", "v250", "v251", "v248", "v249");
#endif
#ifdef MK_T3
                asm volatile("v_mul_f32 v250, v248, v248\n v_mul_f32 v250, v248, v248\n v_mul_f32 v250, v248, v248\n v_mul_f32 v250, v248, v248\n v_mul_f32 v250, v248, v248\n v_mul_f32 v250, v248, v248\n v_mul_f32 v250, v248, v248\n v_mul_f32 v250, v248, v248\n"
                             "v_mul_f32 v250, v248, v248\n v_mul_f32 v250, v248, v248\n v_mul_f32 v250, v248, v248\n v_mul_f32 v250, v248, v248\n v_mul_f32 v250, v248, v248\n v_mul_f32 v250, v248, v248\n v_mul_f32 v250, v248, v248\n v_mul_f32 v250, v248, v248\n" ::: "memory", "v250", "v248");
#endif
            }
#undef RC_LOADOPS
#undef RC_LD2
            rc8_rowsum4(ybuf);
            const float val = kseg == 0 ? ybuf[0] : kseg == 1 ? ybuf[1] : kseg == 2 ? ybuf[2] : ybuf[3];
            if (kseg < 4) *yp = val;
            yp += ystep;
        }
        if (seq < 16) {
            float* sp = state_out + (((((size_t)seq * 2 + l) * 2 + dir) * 12 + head) * 64 + row) * 64 + kseg * 8;
            *(f32x4*)sp = (f32x4){s01.x, s01.y, s23.x, s23.y}; *(f32x4*)(sp + 4) = (f32x4){s45.x, s45.y, s67.x, s67.y};
        }
    }
    asm volatile("s_waitcnt vmcnt(0) lgkmcnt(0)" ::: "memory");
    __builtin_amdgcn_s_barrier();
}
typedef float f32x16 __attribute__((ext_vector_type(16)));
constexpr int HG_BLK = 32768;
__device__ __forceinline__ int hg_tau(int s, int h, int jj) { return 16 * s + 8 * (jj >> 2) + 4 * h + (jj & 3); }

__device__ __forceinline__ void hgrn_prep_item(const float* z, const float* hlb, int l, unsigned char* ws, LAS unsigned char* lds, int item, int tid) {
    LAS float* QS = (LAS float*)lds;
    LAS float* FG = (LAS float*)(lds + 16384);
    LAS float* VV = (LAS float*)(lds + 49152);
    LAS bf16* QT = (LAS bf16*)(lds + 65536);
    LAS bf16* KT = (LAS bf16*)(lds + 81920);
    const int gc = item / 6, head = item % 6, t0 = gc * 32;
    {
        const int k = tid & 127, c = head * 128 + k, p0 = tid >> 7;
        float lbv[2] = {0.f, 0.f};
        if (l == 1) {
#pragma unroll
            for (int d = 0; d < 2; ++d) { const float h0 = hlb[d * 768 + c], h1 = hlb[(2 + d) * 768 + c]; lbv[d] = 1.f / (1.f + __expf(h0 - h1)); }
        }
        float zq[8], zv[8], zf0[8], zf1[8];
#pragma unroll
        for (int i = 0; i < 8; ++i) { const float* zr = z + (size_t)(t0 + p0 + 4 * i) * ZLD + ZC0 + c; zq[i] = zr[0]; zv[i] = zr[2304]; zf0[i] = zr[768]; zf1[i] = zr[1536]; }
#pragma unroll
        for (int i = 0; i < 8; ++i) { const int idx = tid + 512 * i;
            QS[idx] = silu_f(zq[i]); VV[idx] = zv[i];
            FG[idx] = lbv[0] + (1.f - lbv[0]) * sigmoid_f(zf0[i]); FG[4096 + idx] = lbv[1] + (1.f - lbv[1]) * sigmoid_f(zf1[i]); }
    }
    WG_SYNC();
    if (tid < 256) {
        const int k = tid & 127, d = tid >> 7; float b = 0.f;
        for (int p = 0; p < 32; ++p) {
            const int tok = d ? 31 - p : p; const float fg = FG[d * 4096 + tok * 128 + k];
            b += __logf(fg);
            QT[d * 4096 + p * 128 + k] = (bf16)f2bf(QS[tok * 128 + k] * __expf(b));
            KT[d * 4096 + p * 128 + k] = (bf16)f2bf((1.f - fg) * __expf(fminf(-b, 80.f)));
        }
        ((float*)(ws + WS_EB))[((size_t)item * 2 + d) * 128 + k] = __expf(b);
    }
    WG_SYNC();
    const int f = tid >> 6, ln = tid & 63, r = ln & 31, h = ln >> 5, kt = f >> 1, s = f & 1;
#pragma unroll
    for (int d = 0; d < 2; ++d) {
        unsigned char* blk = ws + WS_HF + ((size_t)item * 2 + d) * HG_BLK;
        {
            const int k0 = 32 * kt + 16 * s + 4 * h;
            const LAS unsigned long long* qa = (const LAS unsigned long long*)(QT + d * 4096 + r * 128 + k0);
            const LAS unsigned long long* ka = (const LAS unsigned long long*)(KT + d * 4096 + r * 128 + k0);
            typedef unsigned long long u64x2 __attribute__((ext_vector_type(2)));
            *(GAS u64x2*)(blk + f * 1024 + ln * 16) = (u64x2){qa[0], qa[2]};
            *(GAS u64x2*)(blk + 8192 + f * 1024 + ln * 16) = (u64x2){ka[0], ka[2]};
        }
        {
            unsigned w[4];
#pragma unroll
            for (int jp = 0; jp < 4; ++jp) { const unsigned lo = KT[d * 4096 + hg_tau(s, h, 2 * jp) * 128 + 32 * kt + r], hi = KT[d * 4096 + hg_tau(s, h, 2 * jp + 1) * 128 + 32 * kt + r]; w[jp] = lo | (hi << 16); }
            *(GAS v4u*)(blk + 16384 + f * 1024 + ln * 16) = (v4u){w[0], w[1], w[2], w[3]};
        }
        {
            unsigned w[4];
#pragma unroll
            for (int jp = 0; jp < 4; ++jp) { const int p0 = hg_tau(s, h, 2 * jp), p1 = hg_tau(s, h, 2 * jp + 1);
                const float a = VV[(d ? 31 - p0 : p0) * 128 + 32 * kt + r], b2 = VV[(d ? 31 - p1 : p1) * 128 + 32 * kt + r]; w[jp] = pk2(a, b2); }
            *(GAS v4u*)(blk + 24576 + f * 1024 + ln * 16) = (v4u){w[0], w[1], w[2], w[3]};
        }
    }
    WG_SYNC();
}

__device__ __forceinline__ unsigned hg_cvt_pk(float lo, float hi) { unsigned r; asm("v_cvt_pk_bf16_f32 %0, %1, %2" : "=v"(r) : "v"(lo), "v"(hi)); return r; }
__device__ __forceinline__ bf16x8 hg_pack8(const f32x16& x, int s8) {
    v4u w; w.x = hg_cvt_pk(x[s8 + 0], x[s8 + 1]); w.y = hg_cvt_pk(x[s8 + 2], x[s8 + 3]); w.z = hg_cvt_pk(x[s8 + 4], x[s8 + 5]); w.w = hg_cvt_pk(x[s8 + 6], x[s8 + 7]);
    return __builtin_bit_cast(bf16x8, w);
}
__device__ __forceinline__ void hgrn_scan_wave(unsigned char* ws, const float* state_in, float* state_out, int l, int chain, int vs, int lane) {
    const int dir = chain & 1, head = (chain >> 1) % 6, seq = chain / 12;
    const int T = seq < 16 ? 256 : 1024, base = seq < 16 ? seq * 256 : 4096 + (seq - 16) * 1024, NC = T / 32, gc0 = base / 32;
    const int c = lane & 31, h = lane >> 5;
    float* HO = (float*)(ws + WS_HO);
    f32x16 S[4];
    if (seq < 16) {
#pragma unroll
        for (int kt = 0; kt < 4; ++kt)
#pragma unroll
            for (int r = 0; r < 16; ++r) S[kt][r] = 0.f;
    } else {
        const float* sp = state_in + ((((size_t)(seq - 16) * 2 + l) * 2 + dir) * 6 + head) * 128 * 128 + 32 * vs + c;
#pragma unroll
        for (int kt = 0; kt < 4; ++kt)
#pragma unroll
            for (int r = 0; r < 16; ++r) S[kt][r] = sp[(size_t)(32 * kt + (r & 3) + 8 * (r >> 2) + 4 * h) * 128];
    }
    for (int n = 0; n < NC; ++n) {
        const int gc = gc0 + (dir ? NC - 1 - n : n);
        const unsigned char* blk = ws + WS_HF + (((size_t)gc * 6 + head) * 2 + dir) * HG_BLK + lane * 16;
        const float* eb = (const float*)(ws + WS_EB) + (((size_t)gc * 6 + head) * 2 + dir) * 128;
        bf16x8 QF[8], KF[8];
#pragma unroll
        for (int f = 0; f < 8; ++f) { QF[f] = *(const GAS bf16x8*)(blk + f * 1024); KF[f] = *(const GAS bf16x8*)(blk + 8192 + f * 1024); }
        const bf16x8 VF0 = *(const GAS bf16x8*)(blk + 24576 + (vs * 2 + 0) * 1024), VF1 = *(const GAS bf16x8*)(blk + 24576 + (vs * 2 + 1) * 1024);
        bf16x8 KTF[8];
#pragma unroll
        for (int f = 0; f < 8; ++f) KTF[f] = *(const GAS bf16x8*)(blk + 16384 + f * 1024);
        float zz = 0.f; asm volatile("" : "+v"(zz));
        f32x16 att;
#pragma unroll
        for (int r = 0; r < 16; ++r) att[r] = zz;
#pragma unroll
        for (int f = 0; f < 8; ++f) att = __builtin_amdgcn_mfma_f32_32x32x16_bf16(KF[f], QF[f], att, 0, 0, 0);
        f32x16 O;
#pragma unroll
        for (int r = 0; r < 16; ++r) O[r] = zz;
#pragma unroll
        for (int kt = 0; kt < 4; ++kt) {
            O = __builtin_amdgcn_mfma_f32_32x32x16_bf16(QF[2 * kt + 0], hg_pack8(S[kt], 0), O, 0, 0, 0);
            O = __builtin_amdgcn_mfma_f32_32x32x16_bf16(QF[2 * kt + 1], hg_pack8(S[kt], 8), O, 0, 0, 0);
        }
#pragma unroll
        for (int r = 0; r < 16; ++r) { const int j = (r & 3) + 8 * (r >> 2) + 4 * h; att[r] = j <= c ? att[r] : 0.f; }
        O = __builtin_amdgcn_mfma_f32_32x32x16_bf16(hg_pack8(att, 0), VF0, O, 0, 0, 0);
        O = __builtin_amdgcn_mfma_f32_32x32x16_bf16(hg_pack8(att, 8), VF1, O, 0, 0, 0);
#pragma unroll
        for (int r = 0; r < 16; ++r) { const int p = n * 32 + (r & 3) + 8 * (r >> 2) + 4 * h, t = dir ? T - 1 - p : p;
            HO[((size_t)dir * NTOK + base + t) * 768 + head * 128 + 32 * vs + c] = O[r]; }
#pragma unroll
        for (int kt = 0; kt < 4; ++kt) {
            S[kt] = __builtin_amdgcn_mfma_f32_32x32x16_bf16(KTF[2 * kt + 0], VF0, S[kt], 0, 0, 0);
            S[kt] = __builtin_amdgcn_mfma_f32_32x32x16_bf16(KTF[2 * kt + 1], VF1, S[kt], 0, 0, 0);
#pragma unroll
            for (int g = 0; g < 4; ++g) { const f32x4 e = *(const f32x4*)(eb + 32 * kt + 8 * g + 4 * h);
                S[kt][4 * g + 0] *= e.x; S[kt][4 * g + 1] *= e.y; S[kt][4 * g + 2] *= e.z; S[kt][4 * g + 3] *= e.w; }
        }
    }
    if (seq < 16) {
        float* sp = state_out + ((((size_t)seq * 2 + l) * 2 + dir) * 6 + head) * 128 * 128 + 32 * vs + c;
#pragma unroll
        for (int kt = 0; kt < 4; ++kt)
#pragma unroll
            for (int r = 0; r < 16; ++r) sp[(size_t)(32 * kt + (r & 3) + 8 * (r >> 2) + 4 * h) * 128] = S[kt][r];
    }
}
#define AMP_SUB_BEGIN() do { if (MK_AMP >= 0) amp_s0_ = __builtin_amdgcn_s_memrealtime(); } while (0)
#define AMP_SUB_END(code) do { if (MK_AMP == (code)) { __syncthreads(); if (threadIdx.x == 0) { const unsigned long long t1_ = __builtin_amdgcn_s_memrealtime(), dt_ = (t1_ - amp_s0_) * MK_AMPK; \
        while (__builtin_amdgcn_s_memrealtime() - t1_ < dt_) __builtin_amdgcn_s_sleep(32); } __syncthreads(); } } while (0)
__global__ void __launch_bounds__(NWAVES * 64, 2) mega(Args args) {
    extern __shared__ __attribute__((aligned(16))) unsigned char lds_raw[];
    LAS unsigned char* lds = (LAS unsigned char*)lds_raw;
    volatile LAS unsigned* MISC = (volatile LAS unsigned*)(lds + MISC_OFF);
    const int tid_k = threadIdx.x;
    const int G = gridDim.x; const int vcu = (G % 8 == 0) ? ((int)blockIdx.x % 8) * (G / 8) + (int)blockIdx.x / 8 : (int)blockIdx.x;
    unsigned char* ws = args.ws;
    gu32* ctl = (gu32*)(ws + WS_CTL);
    for (int u = tid_k; u < (LDS_BYTES - LDSCTL_OFF) / 4; u += NWAVES * 64) ((LAS unsigned*)(lds + LDSCTL_OFF))[u] = 0u;
    __syncthreads();
    XcdBarrier bar; bar.bar = (unsigned*)(ctl + CW_BAR); bar.x = 0; bar.st = nullptr;
    if (!MK_PER_PHASE) bar = xcd_barrier_post((unsigned*)(ctl + CW_BAR), MISC + 8);

    float* x = args.out;
    float* out_srw = args.out + (size_t)NTOK * DM;
    float* out_shg = out_srw + (size_t)16 * 2 * 2 * 12 * 64 * 64;
    const float* MOD = (const float*)(ws + WS_MOD);
    bf16* H = (bf16*)(ws + WS_H); bf16* Gb = (bf16*)(ws + WS_G); float* Z = (float*)(ws + WS_Z); bf16* O = (bf16*)(ws + WS_O);

#if MK_AMP >= 0
    unsigned long long amp_t0 = __builtin_amdgcn_s_memrealtime();
#endif
    for (int ph = args.ph_lo; ph < args.ph_hi; ++ph) {
        const int nrep = (MK_REP_S >= 0 && ((ph == 0 && MK_REP_S == 100) || (ph > 0 && ph < N_PHASES - 1 && (ph - 1) % 12 == MK_REP_S))) ? 2 : 1;
        for (int rep = 0; rep < nrep; ++rep) {
        int tid = threadIdx.x; asm volatile("" : "+v"(tid));
        const int lane = tid & 63, wave = __builtin_amdgcn_readfirstlane(tid >> 6);
        if (ph == 0) {
            phase_prologue(args, lds, tid, lane, wave, vcu, G);
        } else if (ph == N_PHASES - 1) {
            phase_norm(x, args.in[30], nullptr, 0, nullptr, x, lane, wave, vcu, G);
        } else {
            const int l = (ph - 1) / 12, s = (ph - 1) % 12;
            const float* mod = MOD + (size_t)l * 3 * NMODC;
            if (s == 0 || s == 3 || s == 9) {
                const int i = s == 0 ? 0 : (s == 3 ? 1 : 2);
                phase_norm(x, args.in[6] + (size_t)(l * 3 + i) * DM, mod, 3 * i, H, nullptr, lane, wave, vcu, G);
            } else if (s == 1 || s == 10) {
                const int i = s == 1 ? 0 : 1;
                pg8::Gemm g{H, (const bf16*)(ws + WS_W13 + (size_t)(l * 2 + i) * SZ_W13), NTOK, 2 * DFF, DM}; pg8::StaticOrder S; S.init(NTOK, 2 * DFF, G, (int)blockIdx.x);
                pg8::EpiSwiglu E{Gb, DFF};
                pg8::gemm_phase<pg8::EpiSwiglu, pg8::StaticOrder, true, true>(lds, g, S, E);
            } else if (s == 2 || s == 8 || s == 11) {
                pg8::Gemm g; float scale; int gi;
                if (s == 8) { g = pg8::Gemm{O, (const bf16*)(ws + WS_WOUT + (size_t)l * SZ_WOUT), NTOK, DM, DM}; scale = 1.f; gi = 5; }
                else { const int i = s == 2 ? 0 : 1; g = pg8::Gemm{Gb, (const bf16*)(ws + WS_W2 + (size_t)(l * 2 + i) * SZ_W2), NTOK, DM, DFF}; scale = 0.5f; gi = s == 2 ? 2 : 8; }
                pg8::StaticOrder S; S.init(NTOK, DM, G, (int)blockIdx.x);
                pg8::EpiResid E{x, DM, mod + (size_t)gi * DM, NMODC, scale};
                pg8::gemm_phase<pg8::EpiResid, pg8::StaticOrder, true, true>(lds, g, S, E);
            } else if (s == 4) {
                pg8::Gemm g{H, (const bf16*)(ws + WS_WIN + (size_t)l * SZ_WIN), NTOK, ZLD, DM}; pg8::StaticOrder S; S.init(NTOK, ZLD, G, (int)blockIdx.x);
                pg8::EpiStoreF32 E{Z, ZLD};
                pg8::gemm_phase<pg8::EpiStoreF32, pg8::StaticOrder, true, true>(lds, g, S, E);
            } else if (s == 5) {
                unsigned long long amp_s0_ = 0; (void)amp_s0_;
                AMP_SUB_BEGIN();
                for (int rr = 0; rr < (MK_REP_S == 50 ? 2 : 1); ++rr)
                for (int item = vcu; item < (NTOK / 128) * 4; item += G)
                    chunk_mlp_item(Z, args.in[14] + (size_t)l * 512, args.in[15] + (size_t)l * 4 * 128 * 128, args.in[16] + (size_t)l * 512, O, lds, item, tid, lane, wave);
                const RwkvW P{args.in[17] + (size_t)l * 2688, args.in[18] + (size_t)l * 2 * BWD, args.in[19] + (size_t)l * 2 * 64 * BWD, args.in[20] + (size_t)l * 2 * BWD,
                              args.in[21] + (size_t)l * 2 * 64 * BWD, args.in[22] + (size_t)l * 128 * BWD, args.in[23] + (size_t)l * BWD, args.in[24] + (size_t)l * BWD, args.in[25] + (size_t)l * BWD};
                AMP_SUB_END(50); AMP_SUB_BEGIN();
                for (int rr = 0; rr < (MK_REP_S == 51 ? 2 : 1); ++rr)
                for (int item = vcu; item < NTOK / 8; item += G) rwkv_prep_item(Z, P, ws, lds, item, tid, lane);
                AMP_SUB_END(51); AMP_SUB_BEGIN();
                for (int rr = 0; rr < (MK_REP_S == 52 ? 2 : 1); ++rr)
                for (int item = vcu; item < (NTOK / 32) * 6; item += G) hgrn_prep_item(Z, args.in[28], l, ws, lds, item, tid);
                AMP_SUB_END(52);
            } else if (s == 6) {
                LAS unsigned char* wl = lds + wave * 18432;
                const unsigned long long sc_t0 = (MK_AMP >= 60 && MK_AMP <= 62) ? __builtin_amdgcn_s_memrealtime() : 0ull;
                int sc_role = -1;
                if (vcu < 96) { sc_role = 60; rwkv_scan_coop8(ws, args.in[2], out_srw, l, 384 + (vcu >> 1), vcu & 1, lds, wave, lane); }
                if (MK_AMP == 60 && sc_role == 60) { if (lane == 0) { const unsigned long long t1_ = __builtin_amdgcn_s_memrealtime(), dt_ = (t1_ - sc_t0) * MK_AMPK; while (__builtin_amdgcn_s_memrealtime() - t1_ < dt_) __builtin_amdgcn_s_sleep(32); } }
                if (vcu >= 96) sc_role = 61;
                {
                    unsigned* q = (unsigned*)(ctl + 64 + l * 32);
                    for (;;) {
                        unsigned idx = 0;
                        if (lane == 0) idx = __hip_atomic_fetch_add(q, 1u, __ATOMIC_RELAXED, __HIP_MEMORY_SCOPE_AGENT);
                        idx = (unsigned)__builtin_amdgcn_readfirstlane((int)idx);
                        if (idx >= 96u + 1536u + 768u) break;
                        if (idx >= 96u && idx < 1632u) { const int r = (int)idx - 96; rwkv_scan_wave<4, 3>(ws, args.in[2], out_srw, l, r >> 2, r & 3, wl, lane); }
                        else { const int h = idx < 96u ? 768 + (int)idx : (int)idx - 1632; hgrn_scan_wave(ws, args.in[3], out_shg, l, h >> 2, h & 3, lane); }
                    }
                }
                if ((MK_AMP >= 61 && MK_AMP <= 62) && sc_role == MK_AMP) { if (lane == 0) { const unsigned long long t1_ = __builtin_amdgcn_s_memrealtime(), dt_ = (t1_ - sc_t0) * MK_AMPK; while (__builtin_amdgcn_s_memrealtime() - t1_ < dt_) __builtin_amdgcn_s_sleep(32); } }
            } else if (s == 7) {
                const int gw = vcu * NWAVES + wave, NGW = G * NWAVES;
                for (int it = gw; it < NTOK * 3; it += NGW) rwkv_post_item4(ws, args.in[26] + (size_t)l * BWD, args.in[27] + (size_t)l * BWD, O, it, lane);
                for (int it = gw; it < NTOK * 3; it += NGW) hgrn_post_item2(Z, ws, args.in[29] + (size_t)l * 128, O, it, lane);
            }
        }
        }
        if (ph + 1 < args.ph_hi) xcd_barrier(bar);
#if MK_AMP >= 0
        {
            const int s_ = (ph - 1) % 12;
            const bool hit = (MK_AMP == 0) ? (ph == 0) : (ph > 0 && ph < N_PHASES - 1 && ((MK_AMP == 1 && (s_ == 0 || s_ == 3 || s_ == 9)) || (MK_AMP == 2 && (s_ == 1 || s_ == 10)) || (MK_AMP == 3 && (s_ == 2 || s_ == 11)) ||
                              (MK_AMP >= 4 && MK_AMP <= 8 && s_ == MK_AMP)));
            if (blockIdx.x == 0 && hit) {
                if (threadIdx.x == 0) { const unsigned long long t1 = __builtin_amdgcn_s_memrealtime(), dt = (t1 - amp_t0) * MK_AMPK; while (__builtin_amdgcn_s_memrealtime() - t1 < dt) __builtin_amdgcn_s_sleep(32); }
                __syncthreads();
            }
            amp_t0 = __builtin_amdgcn_s_memrealtime();
        }
#endif
    }
}

extern "C" void kernel_launch(void* const* d_in, const int* in_sizes, int n_in, void* d_out, int out_size, void* d_ws, size_t ws_size, hipStream_t stream) {
    static int grid = 0;
    if (grid == 0) {
        if (n_in != 31 || ws_size < WS_END) { fprintf(stderr, "kernel_launch: built for 31 inputs and >= %zu bytes of workspace; got n_in %d, ws %zu; nothing launched\n", (size_t)WS_END, n_in, ws_size); grid = -1; return; }
        int dev = 0, cus = 0, per_cu = 0;
        if (hipGetDevice(&dev) != hipSuccess || hipDeviceGetAttribute(&cus, hipDeviceAttributeMultiprocessorCount, dev) != hipSuccess) { fprintf(stderr, "kernel_launch: device query failed\n"); grid = -1; return; }
        if (hipFuncSetAttribute((const void*)mega, hipFuncAttributeMaxDynamicSharedMemorySize, LDS_BYTES) != hipSuccess) { fprintf(stderr, "kernel_launch: hipFuncSetAttribute failed\n"); grid = -1; return; }
        if (hipOccupancyMaxActiveBlocksPerMultiprocessor(&per_cu, (const void*)mega, NWAVES * 64, LDS_BYTES) != hipSuccess || per_cu < 1)
            fprintf(stderr, "kernel_launch: note: occupancy query reports %d workgroups per CU\n", per_cu);
        (void)hipGetLastError();
        if (cus != 256) { fprintf(stderr, "kernel_launch: the scan phase's work map is built for 256 CUs, this device reports %d; nothing launched\n", cus); grid = -1; return; }
        grid = cus;
    }
    if (grid < 0) return;
    if (hipMemsetAsync((char*)d_ws + WS_CTL, 0, CTL_ZERO_BYTES, stream) != hipSuccess) { fprintf(stderr, "kernel_launch: hipMemsetAsync failed\n"); return; }
    Args a{};
    for (int i = 0; i < 31; ++i) a.in[i] = (const float*)d_in[i];
    a.out = (float*)d_out; a.ws = (unsigned char*)d_ws;
#if MK_PER_PHASE
    for (int ph = 0; ph < N_PHASES; ++ph) { a.ph_lo = ph; a.ph_hi = ph + 1; a.li = 0; hipLaunchKernelGGL(mega, dim3(grid), dim3(NWAVES * 64), LDS_BYTES, stream, a); }
#else
    a.ph_lo = 0; a.ph_hi = N_PHASES; a.li = 0;
    hipLaunchKernelGGL(mega, dim3(grid), dim3(NWAVES * 64), LDS_BYTES, stream, a);
#endif
    const hipError_t le = hipPeekAtLastError();
    if (le != hipSuccess) fprintf(stderr, "kernel_launch: launch failed: %s\n", hipGetErrorName(le));
}
```

```cpp
#include <hip/hip_runtime.h>
#include <cstdio>
#include <cstdint>
namespace pg8 {
#define PG8_LAS __attribute__((address_space(3)))
typedef unsigned short bf16_t;
typedef short bf16x8 __attribute__((ext_vector_type(8)));
typedef float f32x4 __attribute__((ext_vector_type(4)));
typedef unsigned u32x4 __attribute__((ext_vector_type(4)));
constexpr int BM = 256, BK = 64, HALF = 128, HTB = HALF * BK * 2  , STAGE_BYTES = 8 * HTB, NXCD = 8, WGM = 8;

__host__ __device__ __forceinline__ int lds_byte(int r, int c) { const int st = (r >> 4) * 2 + (c >> 5), rr = r & 15, cc = c & 31, ob = rr * 64 + cc * 2; return st * 1024 + (ob ^ (((ob >> 9) & 1) << 5)); }
__host__ __device__ __forceinline__ void stage_rc(int b, int& R, int& C) { const int st = b / 1024, sb = b % 1024, swz = sb ^ (((sb >> 9) & 1) << 5); R = (st >> 1) * 16 + swz / 64; C = (st & 1) * 32 + (swz % 64) / 2; }
__host__ __device__ __forceinline__ int perm32(int rho) { const int n = rho >> 4, i = rho & 15; return 8 * (i >> 2) + 4 * n + (i & 3); }

struct Unit { int pm, pn; };
struct Gemm { const bf16_t* A; const bf16_t* Bt; int M, N, K; };

struct StaticOrder {
    int nM, nN, nwg, G, c;
    __host__ __device__ void init(int M, int N, int G_, int c_) { nM = M / BM; nN = N / BM; nwg = nM * nN; G = G_; c = c_; }
    __host__ __device__ bool next(int i, Unit& u) const {
        const long L = (long)i * G + c; if (L >= nwg) return false;
        int wgid = (int)L; { const int q = nwg / NXCD, r = nwg % NXCD, xcd = wgid % NXCD, off = wgid / NXCD; wgid = (xcd < r ? xcd * (q + 1) : r * (q + 1) + (xcd - r) * q) + off; }
        const int nig = WGM * nN, gid = wgid / nig, fm = gid * WGM, gsz = (nM - fm) < WGM ? (nM - fm) : WGM;
        u.pm = fm + ((wgid % nig) % gsz); u.pn = (wgid % nig) / gsz; return true;
    }
    __device__ __forceinline__ void a_ready(const Unit&) const {}
    __device__ __forceinline__ void done(const Unit&) const {}
};

__device__ __forceinline__ unsigned cvt_pk_bf16(float lo, float hi) { unsigned r; asm volatile("v_cvt_pk_bf16_f32 %0, %1, %2" : "=v"(r) : "v"(lo), "v"(hi)); return r; }
typedef float f32x2 __attribute__((ext_vector_type(2)));
__device__ __forceinline__ float silu_f(float x) { return x / (1.f + __expf(-x)); }
struct EpiSwiglu {
    static constexpr bool PERM = true, AFTER_DRAIN = false;
    bf16_t* O; int ldc;
    __device__ __forceinline__ void operator()(const f32x4 (&acc)[2][2][4][2], const Unit& u, int wr, int wc, int fr, int fq) const {
        const int row0 = u.pm * BM + wr * 64 + fr, col0 = u.pn * HALF + wc * 32 + 8 * fq;
#pragma unroll
        for (int ai = 0; ai < 2; ++ai)
#pragma unroll
            for (int m = 0; m < 4; ++m) { bf16_t* rowp = O + (size_t)(row0 + ai * HALF + m * 16) * ldc + col0;
                const f32x4 a0 = acc[ai][0][m][0], a1 = acc[ai][0][m][1], g0 = acc[ai][1][m][0], g1 = acc[ai][1][m][1];
                u32x4 w; w.x = cvt_pk_bf16(silu_f(a0[0]) * g0[0], silu_f(a0[1]) * g0[1]); w.y = cvt_pk_bf16(silu_f(a0[2]) * g0[2], silu_f(a0[3]) * g0[3]);
                w.z = cvt_pk_bf16(silu_f(a1[0]) * g1[0], silu_f(a1[1]) * g1[1]); w.w = cvt_pk_bf16(silu_f(a1[2]) * g1[2], silu_f(a1[3]) * g1[3]);
                *(u32x4*)rowp = w; }
    }
};
struct EpiResid {
    static constexpr bool PERM = false, AFTER_DRAIN = false;
    float* X; int ldc; const float* gate_base; int gate_stride; float scale;
    __device__ __forceinline__ void operator()(const f32x4 (&acc)[2][2][4][2], const Unit& u, int wr, int wc, int fr, int fq) const {
        const int rt = u.pm * BM; const int cond = rt < 4096 ? 0 : 1 + ((rt - 4096) >> 10);
        const float* gate = gate_base + (size_t)cond * gate_stride;
        const int col0 = u.pn * BM + wc * 32 + 4 * fq;
#pragma unroll
        for (int bj = 0; bj < 2; ++bj)
#pragma unroll
            for (int n = 0; n < 2; ++n) { const int c = col0 + bj * HALF + n * 16; const f32x4 gv = *(const f32x4*)(gate + c) * scale;
#pragma unroll
                for (int ai = 0; ai < 2; ++ai)
#pragma unroll
                    for (int m = 0; m < 4; ++m) { float* p = X + (size_t)(rt + ai * HALF + wr * 64 + m * 16 + fr) * ldc + c;
                        const f32x4 old = *(const f32x4*)p; *(f32x4*)p = old + gv * acc[ai][bj][m][n]; } }
    }
};
struct EpiStoreF32 {
    static constexpr bool PERM = false, AFTER_DRAIN = false;
    float* Z; int ldc;
    __device__ __forceinline__ void operator()(const f32x4 (&acc)[2][2][4][2], const Unit& u, int wr, int wc, int fr, int fq) const {
        const int col0 = u.pn * BM + wc * 32 + 4 * fq;
#pragma unroll
        for (int ai = 0; ai < 2; ++ai)
#pragma unroll
            for (int m = 0; m < 4; ++m) { float* rowp = Z + (size_t)(u.pm * BM + ai * HALF + wr * 64 + m * 16 + fr) * ldc + col0;
#pragma unroll
                for (int bj = 0; bj < 2; ++bj)
#pragma unroll
                    for (int n = 0; n < 2; ++n) *(f32x4*)(rowp + bj * HALF + n * 16) = acc[ai][bj][m][n]; }
    }
};
template <class Epi, class Sched, bool ALIGN_EPI = false, bool SP2 = false>
__device__ __forceinline__ void gemm_phase(PG8_LAS unsigned char* lds, const Gemm g, const Sched& S, const Epi& E) {
    int tid0_ = threadIdx.x; asm volatile("" : "+v"(tid0_));
    const int tid = tid0_, wid = __builtin_amdgcn_readfirstlane(tid >> 6), lane = tid & 63, wr = wid >> 2, wc = wid & 3, fr = lane & 15, fq = lane >> 4;
    const int K = g.K, nt = K / BK;
    unsigned voffA[2], voffB[2];
#pragma unroll
    for (int i = 0; i < 2; ++i) { int R, C; stage_rc(tid * 16 + i * 8192, R, C); const int Rb = Epi::PERM ? ((R & ~31) + perm32(R & 31)) : R;
        voffA[i] = (unsigned)(R * K + C) * 2u; voffB[i] = (unsigned)(Rb * K + C) * 2u; }
    const size_t kstep = (size_t)(BK * 2);
    const size_t hstep = (size_t)HALF * K * 2;
    const size_t tstep = 2 * hstep;
    const unsigned ldsw = (unsigned)wid * 1024u;
    const int aoff = lds_byte(wr * 64 + fr, fq * 8), boff = lds_byte(wc * 32 + fr, fq * 8);
#define PG8_SA(b, h) (((b) * 2 + (h)) * HTB)
#define PG8_SB(b, h) ((4 + (b) * 2 + (h)) * HTB)
#define PG8_STAGE(bufoff, gbase, voff) do { _Pragma("unroll") for (int _i = 0; _i < 2; ++_i) \
        __builtin_amdgcn_global_load_lds((const unsigned*)((const char*)(gbase) + (voff)[_i]), (PG8_LAS unsigned*)(lds + (bufoff) + ldsw + _i * 8192), 16, 0, 0); } while (0)
#define PG8_LDA(dst, b, h) do { _Pragma("unroll") for (int m = 0; m < 4; ++m) _Pragma("unroll") for (int k = 0; k < 2; ++k) dst[m][k] = *(const PG8_LAS bf16x8*)(lds + PG8_SA(b, h) + aoff + m * 2048 + k * 1024); } while (0)
#define PG8_LDB(dst, b, h) do { _Pragma("unroll") for (int n = 0; n < 2; ++n) _Pragma("unroll") for (int k = 0; k < 2; ++k) dst[n][k] = *(const PG8_LAS bf16x8*)(lds + PG8_SB(b, h) + boff + n * 2048 + k * 1024); } while (0)
#define PG8_MMA(ai, bj, At, Bt) do { __builtin_amdgcn_s_setprio(1); _Pragma("unroll") for (int m = 0; m < 4; ++m) _Pragma("unroll") for (int n = 0; n < 2; ++n) _Pragma("unroll") for (int k = 0; k < 2; ++k) \
        acc[ai][bj][m][n] = __builtin_amdgcn_mfma_f32_16x16x32_bf16(Bt[n][k], At[m][k], acc[ai][bj][m][n], 0, 0, 0); __builtin_amdgcn_s_setprio(0); } while (0)
#define PG8_WAIT_V(n) asm volatile("s_waitcnt vmcnt(" #n ")" ::: "memory")
#define PG8_WAIT_L(n) asm volatile("s_waitcnt lgkmcnt(" #n ")" ::: "memory")
#define PG8_BAR __builtin_amdgcn_s_barrier()
#define PG8_SCHED __builtin_amdgcn_sched_barrier(0)
    Unit cur, nxt; int ui = 0;
    if (!S.next(0, cur)) return;
    f32x4 acc[2][2][4][2];
#pragma unroll
    for (int a = 0; a < 2; ++a)
#pragma unroll
        for (int b = 0; b < 2; ++b)
#pragma unroll
            for (int m = 0; m < 4; ++m)
#pragma unroll
                for (int n = 0; n < 2; ++n) acc[a][b][m][n] = (f32x4){0.f, 0.f, 0.f, 0.f};
    bf16x8 At[4][2], B0[2][2], B1[2][2];
    const char* cA = (const char*)g.A + (size_t)cur.pm * tstep; const char* cB = (const char*)g.Bt + (size_t)cur.pn * tstep;
    S.a_ready(cur);
    if constexpr (SP2) {
        PG8_STAGE(PG8_SB(0, 0), cB, voffB); PG8_STAGE(PG8_SB(0, 1), cB + hstep, voffB); PG8_STAGE(PG8_SA(0, 0), cA, voffA); PG8_STAGE(PG8_SA(0, 1), cA + hstep, voffA);
        if (wr == 1) PG8_BAR;
        PG8_WAIT_V(2); PG8_BAR;
        PG8_STAGE(PG8_SB(1, 0), cB + kstep, voffB); PG8_STAGE(PG8_SA(1, 0), cA + kstep, voffA); PG8_STAGE(PG8_SB(1, 1), cB + hstep + kstep, voffB);
        PG8_WAIT_V(6); PG8_BAR;
    } else {
        PG8_STAGE(PG8_SB(0, 0), cB, voffB); PG8_STAGE(PG8_SA(0, 0), cA, voffA); PG8_STAGE(PG8_SB(0, 1), cB + hstep, voffB); PG8_STAGE(PG8_SA(0, 1), cA + hstep, voffA);
        if (wr == 1) PG8_BAR;
        PG8_WAIT_V(4); PG8_BAR;
        PG8_STAGE(PG8_SB(1, 0), cB + kstep, voffB); PG8_STAGE(PG8_SA(1, 0), cA + kstep, voffA); PG8_STAGE(PG8_SB(1, 1), cB + hstep + kstep, voffB);
        PG8_WAIT_V(6); PG8_BAR;
    }
    for (;;) {
        const bool has_next = S.next(ui + 1, nxt);
        const char* nA = has_next ? (const char*)g.A + (size_t)nxt.pm * tstep : cA; const char* nB = has_next ? (const char*)g.Bt + (size_t)nxt.pn * tstep : cB;
        for (int t = 0; t < nt; t += 2) {
            const bool last = (t == nt - 2);
            const char* a1 = cA + (size_t)(t + 1) * kstep;
            const char* a2 = last ? nA : cA + (size_t)(t + 2) * kstep; const char* b2 = last ? nB : cB + (size_t)(t + 2) * kstep;
            const char* a3 = a2 + kstep; const char* b3 = b2 + kstep;
            if (last && has_next) S.a_ready(nxt);
            if constexpr (SP2) {
            PG8_LDB(B0, 0, 0); PG8_LDB(B1, 0, 1); PG8_SCHED; PG8_LDA(At, 0, 0); PG8_STAGE(PG8_SA(1, 1), a1 + hstep, voffA);
            PG8_WAIT_V(8); PG8_WAIT_L(0); PG8_BAR; PG8_MMA(0, 0, At, B0); PG8_MMA(0, 1, At, B1); PG8_BAR; PG8_SCHED;
            PG8_LDA(At, 0, 1); PG8_STAGE(PG8_SB(0, 0), b2, voffB); PG8_STAGE(PG8_SB(0, 1), b2 + hstep, voffB); PG8_STAGE(PG8_SA(0, 0), a2, voffA);
            PG8_WAIT_V(8); PG8_WAIT_L(0); PG8_BAR; PG8_MMA(1, 0, At, B0); PG8_MMA(1, 1, At, B1); PG8_BAR; PG8_SCHED;
            PG8_LDB(B0, 1, 0); PG8_LDB(B1, 1, 1); PG8_SCHED; PG8_LDA(At, 1, 0); PG8_STAGE(PG8_SA(0, 1), a2 + hstep, voffA);
            PG8_WAIT_V(8); PG8_WAIT_L(0); PG8_BAR; PG8_MMA(0, 0, At, B0); PG8_MMA(0, 1, At, B1); PG8_BAR; PG8_SCHED;
            PG8_LDA(At, 1, 1); PG8_STAGE(PG8_SB(1, 0), b3, voffB); PG8_STAGE(PG8_SB(1, 1), b3 + hstep, voffB); PG8_STAGE(PG8_SA(1, 0), a3, voffA);
            PG8_WAIT_V(8); PG8_WAIT_L(0); PG8_BAR; PG8_MMA(1, 0, At, B0); PG8_MMA(1, 1, At, B1); PG8_BAR; PG8_SCHED;
            } else {
            PG8_LDB(B0, 0, 0); PG8_SCHED; PG8_LDA(At, 0, 0); PG8_STAGE(PG8_SA(1, 1), a1 + hstep, voffA);
            PG8_WAIT_L(8); PG8_BAR; PG8_WAIT_L(0); PG8_MMA(0, 0, At, B0); PG8_BAR; PG8_SCHED;
            PG8_LDB(B1, 0, 1); PG8_STAGE(PG8_SB(0, 0), b2, voffB);
            PG8_BAR; PG8_WAIT_L(0); PG8_MMA(0, 1, At, B1); PG8_BAR;
            PG8_LDA(At, 0, 1); PG8_STAGE(PG8_SA(0, 0), a2, voffA);
            PG8_BAR; PG8_WAIT_L(0); PG8_MMA(1, 0, At, B0); PG8_BAR; PG8_SCHED;
            PG8_STAGE(PG8_SB(0, 1), b2 + hstep, voffB);
            PG8_WAIT_V(6); PG8_BAR; PG8_MMA(1, 1, At, B1); PG8_BAR;
            PG8_LDB(B0, 1, 0); PG8_SCHED; PG8_LDA(At, 1, 0); PG8_STAGE(PG8_SA(0, 1), a2 + hstep, voffA);
            PG8_WAIT_L(8); PG8_BAR; PG8_WAIT_L(0); PG8_MMA(0, 0, At, B0); PG8_BAR; PG8_SCHED;
            PG8_LDB(B1, 1, 1); PG8_STAGE(PG8_SB(1, 0), b3, voffB);
            PG8_BAR; PG8_WAIT_L(0); PG8_MMA(0, 1, At, B1); PG8_BAR;
            PG8_LDA(At, 1, 1); PG8_STAGE(PG8_SA(1, 0), a3, voffA);
            PG8_BAR; PG8_WAIT_L(0); PG8_MMA(1, 0, At, B0); PG8_BAR; PG8_SCHED;
            PG8_STAGE(PG8_SB(1, 1), b3 + hstep, voffB);
            PG8_WAIT_V(6); PG8_BAR; PG8_MMA(1, 1, At, B1); PG8_BAR;
            }
        }
        if constexpr (ALIGN_EPI) { if (wr == 0) PG8_BAR; }
        if constexpr (!Epi::AFTER_DRAIN) { E(acc, cur, wr, wc, fr, fq); S.done(cur); }
        if (!has_next) break;
#pragma unroll
        for (int a = 0; a < 2; ++a)
#pragma unroll
            for (int b = 0; b < 2; ++b)
#pragma unroll
                for (int m = 0; m < 4; ++m)
#pragma unroll
                    for (int n = 0; n < 2; ++n) acc[a][b][m][n] = (f32x4){0.f, 0.f, 0.f, 0.f};
        cur = nxt; cA = nA; cB = nB; ++ui;
        if constexpr (ALIGN_EPI) { if (wr == 1) PG8_BAR; }
    }
    PG8_WAIT_V(0);
    if constexpr (!ALIGN_EPI) { if (wr == 0) PG8_BAR; }
    PG8_BAR;
    if constexpr (Epi::AFTER_DRAIN) { E.fused(acc, cur, wr, wc, fr, fq, lds, wid, lane); S.done(cur); }
#undef PG8_SA
#undef PG8_SB
#undef PG8_STAGE
#undef PG8_LDA
#undef PG8_LDB
#undef PG8_MMA
#undef PG8_WAIT_V
#undef PG8_WAIT_L
#undef PG8_BAR
#undef PG8_SCHED
}
}
#define GAS __attribute__((address_space(1)))
#define LAS __attribute__((address_space(3)))
typedef unsigned short bf16;
typedef unsigned v4u __attribute__((ext_vector_type(4)));
typedef float f32x4 __attribute__((ext_vector_type(4)));
typedef short bf16x8 __attribute__((ext_vector_type(8)));
typedef GAS unsigned gu32;
typedef GAS unsigned long long gu64;
#define RLX_AGENT __ATOMIC_RELAXED, __HIP_MEMORY_SCOPE_AGENT
#define LDS_WAIT() asm volatile("s_waitcnt lgkmcnt(0)" ::: "memory")
#define VM_WAIT() asm volatile("s_waitcnt vmcnt(0)" ::: "memory")
__device__ __forceinline__ unsigned long long rt() { return __builtin_amdgcn_s_memrealtime(); }
__device__ __forceinline__ unsigned f2bf(float f) { unsigned u = __builtin_bit_cast(unsigned, f); return (u + 0x7fffu + ((u >> 16) & 1u)) >> 16; }
__device__ __forceinline__ unsigned pk2(float lo, float hi) { return f2bf(lo) | (f2bf(hi) << 16); }
#define XB_TMO      128
#define XB_XCNT(j)  (256  + 64 * (j))
#define XB_XSUB(j)  (1280 + 64 * (j))
#define XB_XGEN(j)  (2304 + 64 * (j))
#define XB_TOP      3328
#define XB_TOPGEN   3392
#define XCD_BAR_WORDS 3456
#define XB_SPIN_CAP (1u << 18)

__device__ __forceinline__ unsigned xb_ld(unsigned* p)              { return __hip_atomic_load(p, __ATOMIC_RELAXED, __HIP_MEMORY_SCOPE_AGENT); }
__device__ __forceinline__ unsigned xb_add(unsigned* p, unsigned v) { return __hip_atomic_fetch_add(p, v, __ATOMIC_RELAXED, __HIP_MEMORY_SCOPE_AGENT); }
__device__ __forceinline__ unsigned xb_xcc_id() { return (unsigned)__builtin_amdgcn_s_getreg((3 << 11) | 20) & 0xFu; }
#define XB_SPIN(cond, bar) do { unsigned _sp = 0; while (cond) { __builtin_amdgcn_s_sleep(1); \
    if ((++_sp & 255u) == 0u) { if (xb_ld(&(bar)[XB_TMO])) break; if (_sp > XB_SPIN_CAP) { atomicAdd(&(bar)[XB_TMO], 1u); break; } } } } while (0)

struct XcdBarrier {
    unsigned* bar; unsigned x;
    volatile LAS unsigned* st;
};

__device__ __forceinline__ XcdBarrier xcd_barrier_post(unsigned* bar, volatile LAS unsigned* st) {
    XcdBarrier b; b.bar = bar; b.x = xb_xcc_id(); b.st = st;
    if (threadIdx.x == 0) (void)xb_add(&bar[XB_XCNT(b.x)], 1u);
    return b;
}
__device__ __forceinline__ void xcd_barrier_complete(unsigned* bar, unsigned x, unsigned& nloc, unsigned& nx) {
    const unsigned G = gridDim.x * gridDim.y * gridDim.z;
    unsigned sum, cnt, mine, sp = 0u;
    for (;;) {
        sum = 0u; cnt = 0u; mine = 0u;
#pragma unroll
        for (unsigned j = 0; j < 16; ++j) { const unsigned c = xb_ld(&bar[XB_XCNT(j)]); sum += c; cnt += (c > 0u) ? 1u : 0u; mine = (j == x) ? c : mine; }
        if (sum == G) break;
        __builtin_amdgcn_s_sleep(1);
        if ((++sp & 255u) == 0u) { if (xb_ld(&bar[XB_TMO])) break; if (sp > XB_SPIN_CAP) { atomicAdd(&bar[XB_TMO], 1u); break; } }
    }
    nloc = mine > 0u ? mine : 1u; nx = cnt > 0u ? cnt : 1u;
}

__device__ __forceinline__ void xcd_barrier(const XcdBarrier& b) {
    asm volatile("s_waitcnt vmcnt(0)" ::: "memory");
    __syncthreads();
    if (threadIdx.x == 0) {
        unsigned* bar = b.bar;
        __builtin_amdgcn_s_waitcnt(0);
        unsigned nloc = b.st[0], nx = b.st[1];
        if (nloc == 0u) { xcd_barrier_complete(bar, b.x, nloc, nx); b.st[0] = nloc; b.st[1] = nx; }
        const unsigned old = xb_add(&bar[XB_XSUB(b.x)], 1u);
        const unsigned gen = old / nloc;
        if (old + 1u == (gen + 1u) * nloc) {
            __builtin_amdgcn_fence(__ATOMIC_RELEASE, "agent");
            asm volatile("s_waitcnt vmcnt(0)" ::: "memory");
            const unsigned og = xb_add(&bar[XB_TOP], 1u);
            const unsigned tg = og / nx;
            if (og + 1u == (tg + 1u) * nx) xb_add(&bar[XB_TOPGEN], 1u);
            else XB_SPIN(xb_ld(&bar[XB_TOPGEN]) == tg, bar);
            __builtin_amdgcn_fence(__ATOMIC_ACQUIRE, "agent");
            xb_add(&bar[XB_XGEN(b.x)], 1u);
            asm volatile("s_waitcnt vmcnt(0)" ::: "memory");
        } else {
            XB_SPIN(xb_ld(&bar[XB_XGEN(b.x)]) == gen, bar);
            __builtin_amdgcn_fence(__ATOMIC_ACQUIRE, "agent");
            asm volatile("s_waitcnt vmcnt(0)" ::: "memory");
        }
    }
    __syncthreads();
}
constexpr int NWAVES = 8;
#ifndef MK_REP_S
#define MK_REP_S -1
#endif
#ifndef MK_AMP
#define MK_AMP -1
#endif
#ifndef MK_AMPK
#define MK_AMPK 4
#endif
#ifndef MK_PER_PHASE
#define MK_PER_PHASE 0
#endif
constexpr int DM = 2048, NTOK = 6144, DFF = 5632, INC = 7552, ZLD = 7680, BWD = 768, NMODC = 18432;
constexpr int ZB0 = 1024, ZC0 = 3712;
constexpr int N_PHASES = 26;
constexpr size_t MiB = 1u << 20;
constexpr size_t WS_CTL = 0, CTL_ZERO_BYTES = 1 * MiB;
constexpr size_t WS_MOD = 1 * MiB;
constexpr size_t WS_W13 = 2 * MiB, SZ_W13 = 44 * MiB;
constexpr size_t WS_W2 = WS_W13 + 4 * SZ_W13, SZ_W2 = 22 * MiB;
constexpr size_t WS_WIN = WS_W2 + 4 * SZ_W2, SZ_WIN = 30 * MiB;
constexpr size_t WS_WOUT = WS_WIN + 2 * SZ_WIN, SZ_WOUT = 8 * MiB;
constexpr size_t WS_H = WS_WOUT + 2 * SZ_WOUT;
constexpr size_t WS_G = WS_H + 24 * MiB;
constexpr size_t WS_Z = WS_G + 66 * MiB;
constexpr size_t WS_O = WS_Z + 180 * MiB;
constexpr size_t SZ_T = 18 * MiB;
constexpr size_t WS_R = WS_O + 24 * MiB, WS_V = WS_R + SZ_T, WS_KK = WS_V + SZ_T, WS_GATE = WS_KK + SZ_T;
constexpr size_t WS_W = WS_GATE + SZ_T, WS_KD = WS_W + 2 * SZ_T, WS_BV = WS_KD + 2 * SZ_T, WS_Y = WS_BV + 2 * SZ_T;
constexpr size_t WS_BON = WS_Y + 2 * SZ_T;
constexpr size_t WS_QS = WS_BON + 1 * MiB, WS_FG = WS_QS + SZ_T, WS_HO = WS_FG + 2 * SZ_T;
constexpr size_t WS_HF = WS_HO + 2 * SZ_T, WS_EB = WS_HF + 72 * MiB, WS_LW = WS_EB + 2 * MiB, WS_END = WS_LW + 2 * MiB;
constexpr int CW_BAR = 4096;
constexpr int RING_BYTES = 135168;
constexpr int LDSCTL_OFF = 147456, MISC_OFF = LDSCTL_OFF + 320;
constexpr int LDS_BYTES = 147456 + 1024;

__device__ __forceinline__ float sigmoid_f(float x) { return 1.f / (1.f + __expf(-x)); }
__device__ __forceinline__ float silu_f(float x) { return x / (1.f + __expf(-x)); }
__device__ __forceinline__ float gelu_tanh(float x) { const float u = 0.7978845608028654f * (x + 0.044715f * x * x * x); return 0.5f * x * (1.f + tanhf(u)); }
__device__ __forceinline__ float wave_sum(float v) {
    asm volatile("s_nop 1\n v_add_f32_dpp %0, %0, %0 quad_perm:[1,0,3,2] row_mask:0xf bank_mask:0xf\n s_nop 1\n v_add_f32_dpp %0, %0, %0 quad_perm:[2,3,0,1] row_mask:0xf bank_mask:0xf\n"
                 "s_nop 1\n v_add_f32_dpp %0, %0, %0 row_ror:4 row_mask:0xf bank_mask:0xf\n s_nop 1\n v_add_f32_dpp %0, %0, %0 row_ror:8 row_mask:0xf bank_mask:0xf\n" : "+v"(v));
    { const unsigned u = __builtin_bit_cast(unsigned, v); auto r = __builtin_amdgcn_permlane16_swap(u, u, false, false); v = __builtin_bit_cast(float, (unsigned)r[0]) + __builtin_bit_cast(float, (unsigned)r[1]); }
    { const unsigned u = __builtin_bit_cast(unsigned, v); auto r = __builtin_amdgcn_permlane32_swap(u, u, false, false); v = __builtin_bit_cast(float, (unsigned)r[0]) + __builtin_bit_cast(float, (unsigned)r[1]); }
    return v;
}
#define WG_SYNC() do { asm volatile("s_waitcnt vmcnt(0) lgkmcnt(0)" ::: "memory"); __builtin_amdgcn_s_barrier(); asm volatile("" ::: "memory"); } while (0)

__device__ __forceinline__ void conv_item(const float* W, int K, int N, bf16* WT, int mode, LAS float* scr, int item, int lane) {
    const int nblk = N / 32, kb = item / nblk, nb = item % nblk, k0 = 64 * kb, n0 = 32 * nb;
#pragma unroll 8
    for (int i = 0; i < 32; ++i) { const int kk = 2 * i + (lane >> 5); scr[kk * 33 + (lane & 31)] = W[(size_t)(k0 + kk) * N + n0 + (lane & 31)]; }
    LDS_WAIT(); asm volatile("" ::: "memory");
    const int rowbase = mode == 0 ? n0 : (256 * (n0 >> 7) + (n0 & 127) + (mode == 2 ? 128 : 0));
    const int c = lane & 7;
#pragma unroll
    for (int j = 0; j < 4; ++j) { const int n = (lane >> 3) + 8 * j; const LAS float* s = scr + (8 * c) * 33 + n;
        v4u o; o.x = pk2(s[0 * 33], s[1 * 33]); o.y = pk2(s[2 * 33], s[3 * 33]); o.z = pk2(s[4 * 33], s[5 * 33]); o.w = pk2(s[6 * 33], s[7 * 33]);
        *(GAS v4u*)(WT + (size_t)(rowbase + n) * K + k0 + 8 * c) = o; }
    LDS_WAIT(); asm volatile("" ::: "memory");
}

struct Args { const float* in[31]; float* out; unsigned char* ws; int ph_lo, ph_hi, li, pad; };

__device__ __forceinline__ void conv_ffn(const Args& A, int l, int i, LAS float* scr, int gw, int NGW, int lane) {
    constexpr int I_13 = (DM / 64) * (DFF / 32), I_2 = (DFF / 64) * (DM / 32);
    const float* w1 = A.in[9] + (size_t)(l * 2 + i) * DM * DFF; const float* w3 = A.in[10] + (size_t)(l * 2 + i) * DM * DFF; const float* w2 = A.in[11] + (size_t)(l * 2 + i) * DFF * DM;
    bf16* W13 = (bf16*)(A.ws + WS_W13 + (size_t)(l * 2 + i) * SZ_W13); bf16* W2 = (bf16*)(A.ws + WS_W2 + (size_t)(l * 2 + i) * SZ_W2);
    for (int it = gw; it < I_13; it += NGW) conv_item(w1, DM, DFF, W13, 1, scr, it, lane);
    for (int it = gw; it < I_13; it += NGW) conv_item(w3, DM, DFF, W13, 2, scr, it, lane);
    for (int it = gw; it < I_2; it += NGW) conv_item(w2, DFF, DM, W2, 0, scr, it, lane);
}
__device__ __forceinline__ void conv_inout(const Args& A, int l, LAS float* scr, int gw, int NGW, int lane) {
    constexpr int I_IN = (DM / 64) * (INC / 32), I_OUT = (DM / 64) * (DM / 32);
    bf16* WIN = (bf16*)(A.ws + WS_WIN + (size_t)l * SZ_WIN); bf16* WOUT = (bf16*)(A.ws + WS_WOUT + (size_t)l * SZ_WOUT);
    for (int it = gw; it < I_IN; it += NGW) conv_item(A.in[12] + (size_t)l * DM * INC, DM, INC, WIN, 0, scr, it, lane);
    for (int it = gw; it < I_OUT; it += NGW) conv_item(A.in[13] + (size_t)l * DM * DM, DM, DM, WOUT, 0, scr, it, lane);
    for (int i = gw * 64 + lane; i < 128 * DM / 8; i += NGW * 64) ((GAS v4u*)(WIN + (size_t)INC * DM))[i] = (v4u){0u, 0u, 0u, 0u};
}
__device__ __forceinline__ void conv_set(const Args& A, int set, LAS float* scr, int gw, int NGW, int lane) {
    if (set == 0) { for (int l = 0; l < 2; ++l) {
        bf16* LW = (bf16*)(A.ws + WS_LW + (size_t)l * MiB);
        for (int it = gw; it < 144; it += NGW) {
            if (it < 48) conv_item(A.in[19] + ((size_t)l * 2 + it / 24) * 64 * BWD, 64, BWD, LW + (size_t)(it / 24) * BWD * 64, 0, scr, it % 24, lane);
            else if (it < 96) conv_item(A.in[21] + ((size_t)l * 2 + (it - 48) / 24) * 64 * BWD, 64, BWD, LW + (size_t)(2 + (it - 48) / 24) * BWD * 64, 0, scr, (it - 48) % 24, lane);
            else conv_item(A.in[22] + (size_t)l * 128 * BWD, 128, BWD, LW + (size_t)4 * BWD * 64, 0, scr, it - 96, lane);
        }
        conv_ffn(A, l, 0, scr, gw, NGW, lane); conv_ffn(A, l, 1, scr, gw, NGW, lane); conv_inout(A, l, scr, gw, NGW, lane); } }
}

__device__ __forceinline__ void phase_prologue(const Args& A, LAS unsigned char* lds, int tid, int lane, int wave, int vcu, int G) {
    unsigned char* ws = A.ws;
    conv_set(A, 0, (LAS float*)(lds + wave * 8448), vcu * NWAVES + wave, G * NWAVES, lane);
    {
        const f32x4* xp = (const f32x4*)A.in[0]; const f32x4* xs = (const f32x4*)A.in[1]; f32x4* xo = (f32x4*)A.out;
        constexpr int NP = 4096 * DM / 4, NALL = NTOK * DM / 4;
        for (int i = vcu * 512 + tid; i < NALL; i += G * 512) xo[i] = i < NP ? xp[i] : xs[i - NP];
    }
    WG_SYNC();
    {
        LAS float* sct = (LAS float*)(lds + 0);
        LAS float* red = (LAS float*)(lds + 32768);
        for (int i = tid; i < 3 * DM; i += 512) { const int cd = i / DM, k = i % DM; const float s = cd == 0 ? A.in[5][k] : A.in[4][(cd - 1) * DM + k]; sct[i] = silu_f(s); }
        WG_SYNC();
        float* MOD = (float*)(ws + WS_MOD);
        for (int item = vcu; item < 2 * (NMODC / 64); item += G) {
            const int l = item / (NMODC / 64), j0 = (item % (NMODC / 64)) * 64;
            const float* w = A.in[7] + (size_t)l * DM * NMODC + j0 + lane;
            float a0 = 0.f, a1 = 0.f, a2 = 0.f;
#pragma unroll 8
            for (int k = wave * 256; k < wave * 256 + 256; ++k) { const float wv = w[(size_t)k * NMODC]; a0 += sct[k] * wv; a1 += sct[DM + k] * wv; a2 += sct[2 * DM + k] * wv; }
            red[(wave * 3 + 0) * 64 + lane] = a0; red[(wave * 3 + 1) * 64 + lane] = a1; red[(wave * 3 + 2) * 64 + lane] = a2;
            WG_SYNC();
            if (tid < 192) { const int cd = tid >> 6; float s = A.in[8][(size_t)l * NMODC + j0 + lane];
#pragma unroll
                for (int w8 = 0; w8 < 8; ++w8) s += red[(w8 * 3 + cd) * 64 + lane];
                MOD[(size_t)(l * 3 + cd) * NMODC + j0 + lane] = s; }
            WG_SYNC();
        }
    }
}

__device__ __forceinline__ void phase_norm(const float* x, const float* g, const float* mod, int sh_idx, bf16* H, float* xout, int lane, int wave, int vcu, int G) {
    const int gw = vcu * NWAVES + wave, NGW = G * NWAVES;
    for (int m = gw; m < NTOK; m += NGW) {
        const GAS f32x4* xr = (const GAS f32x4*)(x + (size_t)m * DM) + lane;
        f32x4 v[8]; float ss = 0.f;
#pragma unroll
        for (int j = 0; j < 8; ++j) { v[j] = xr[64 * j]; ss += (v[j].x * v[j].x + v[j].y * v[j].y) + (v[j].z * v[j].z + v[j].w * v[j].w); }
        const float rstd = rsqrtf(wave_sum(ss) * (1.f / DM) + 1e-6f);
        if (mod) {
            const int cond = m < 4096 ? 0 : 1 + ((m - 4096) >> 10);
            const float* sh = mod + (size_t)cond * NMODC + sh_idx * DM; const float* sc = sh + DM;
            GAS unsigned long long* o8 = (GAS unsigned long long*)(H + (size_t)m * DM) + lane;
#pragma unroll
            for (int j = 0; j < 8; ++j) { const int col = 4 * (lane + 64 * j);
                const f32x4 g4 = *(const f32x4*)(g + col), sc4 = *(const f32x4*)(sc + col), sh4 = *(const f32x4*)(sh + col);
                const f32x4 o = v[j] * rstd * g4 * (sc4 + 1.f) + sh4;
                o8[64 * j] = (unsigned long long)pk2(o.x, o.y) | ((unsigned long long)pk2(o.z, o.w) << 32); }
        } else {
            GAS f32x4* xo = (GAS f32x4*)(xout + (size_t)m * DM) + lane;
#pragma unroll
            for (int j = 0; j < 8; ++j) { const int col = 4 * (lane + 64 * j); const f32x4 g4 = *(const f32x4*)(g + col); xo[64 * j] = v[j] * rstd * g4; }
        }
    }
}

__device__ __forceinline__ void st_bf16(bf16* p, float v) { *p = (bf16)f2bf(v); }

typedef float f32x16a __attribute__((ext_vector_type(16)));
__device__ __forceinline__ unsigned cm_cvt_pk(float lo, float hi) { unsigned r; asm("v_cvt_pk_bf16_f32 %0, %1, %2" : "=v"(r) : "v"(lo), "v"(hi)); return r; }
__device__ __forceinline__ void chunk_mlp_item(const float* z, const float* ng, const float* wsp, const float* bs, bf16* o, LAS unsigned char* lds, int item, int tid, int lane, int wave) {
    constexpr int VROW = 272;
    const int chunk = item >> 2, g = item & 3, tok0 = chunk * 128;
    const float ng0 = ng[g * 128 + lane], ng1 = ng[g * 128 + lane + 64];
    {
        float za[8][4];
#pragma unroll
        for (int i = 0; i < 8; ++i) { const float* zr = z + (size_t)(tok0 + 2 * wave + 16 * i) * ZLD + 512 + g * 128; za[i][0] = zr[lane]; za[i][1] = zr[lane + 64]; za[i][2] = zr[ZLD + lane]; za[i][3] = zr[ZLD + lane + 64]; }
#pragma unroll
        for (int i = 0; i < 8; ++i) {
            const int q = 2 * wave + 16 * i;
            const float a0 = gelu_tanh(za[i][0]), b0 = gelu_tanh(za[i][1]), a1 = gelu_tanh(za[i][2]), b1 = gelu_tanh(za[i][3]);
            const float rs0 = rsqrtf(wave_sum(a0 * a0 + b0 * b0) * (1.f / 128.f) + 1e-6f), rs1 = rsqrtf(wave_sum(a1 * a1 + b1 * b1) * (1.f / 128.f) + 1e-6f);
            *(LAS unsigned*)(lds + lane * VROW + q * 2) = pk2(a0 * rs0 * ng0, a1 * rs1 * ng0);
            *(LAS unsigned*)(lds + (lane + 64) * VROW + q * 2) = pk2(b0 * rs0 * ng1, b1 * rs1 * ng1);
        }
    }
    WG_SYNC();
    const int fr = lane & 15, fq = lane >> 4;
    f32x4 acc[8];
#pragma unroll
    for (int ct = 0; ct < 8; ++ct) acc[ct] = (f32x4){0.f, 0.f, 0.f, 0.f};
    const float* wrow = wsp + ((size_t)g * 128 + 16 * wave + fr) * 128 + 8 * fq;
    f32x4 wa[8];
#pragma unroll
    for (int ks = 0; ks < 4; ++ks) { wa[2 * ks] = *(const f32x4*)(wrow + 32 * ks); wa[2 * ks + 1] = *(const f32x4*)(wrow + 32 * ks + 4); }
#pragma unroll
    for (int ks = 0; ks < 4; ++ks) {
        v4u aw; aw.x = pk2(wa[2 * ks].x, wa[2 * ks].y); aw.y = pk2(wa[2 * ks].z, wa[2 * ks].w); aw.z = pk2(wa[2 * ks + 1].x, wa[2 * ks + 1].y); aw.w = pk2(wa[2 * ks + 1].z, wa[2 * ks + 1].w);
        const bf16x8 af = __builtin_bit_cast(bf16x8, aw);
#pragma unroll
        for (int ct = 0; ct < 8; ++ct) {
            const bf16x8 bfr = *(const LAS bf16x8*)(lds + (16 * ct + fr) * VROW + (32 * ks + 8 * fq) * 2);
            acc[ct] = __builtin_amdgcn_mfma_f32_16x16x32_bf16(af, bfr, acc[ct], 0, 0, 0);
        }
    }
#pragma unroll
    for (int r = 0; r < 4; ++r) {
        const int p = 16 * wave + 4 * fq + r; const float bias = bs[g * 128 + p];
        const float* zu = z + (size_t)(tok0 + p) * ZLD + g * 128; bf16* op = o + (size_t)(tok0 + p) * DM + g * 128;
#pragma unroll
        for (int ct = 0; ct < 8; ++ct) { const int c = 16 * ct + fr; st_bf16(op + c, gelu_tanh(zu[c]) * (acc[ct][r] + bias)); }
    }
    WG_SYNC();
}

struct RwkvW { const float *mu, *w0, *w2, *a0, *a2, *g2, *kkw, *kaw, *rk; };
__device__ __forceinline__ void rwkv_prep_item(const float* z, const RwkvW P, unsigned char* ws, LAS unsigned char* lds, int item, int tid, int lane) {
    LAS float* zm = (LAS float*)lds;
    LAS float* xl = (LAS float*)(lds + 73728);
    float* R = (float*)(ws + WS_R); float* V = (float*)(ws + WS_V); float* KK = (float*)(ws + WS_KK); float* GATE = (float*)(ws + WS_GATE);
    float* W = (float*)(ws + WS_W); float* KD = (float*)(ws + WS_KD); float* Bv = (float*)(ws + WS_BV); float* BON = (float*)(ws + WS_BON);
    const int tok0 = item * 8;
#pragma unroll 1
    for (int th = 0; th < 2; ++th) {
        float cur[4][6], prv[4][6], nxt[4][6];
#pragma unroll
        for (int t4i = 0; t4i < 4; ++t4i) {
            const int m = tok0 + th * 4 + t4i; int t, T;
            if (m < 4096) { t = m & 255; T = 256; } else { t = (m - 4096) & 1023; T = 1024; }
            const float* zc = z + (size_t)m * ZLD + ZB0;
            const bool hp = t > 0, hn = t < T - 1;
#pragma unroll
            for (int i = 0; i < 6; ++i) { const int c = tid + 512 * i; const bool ok = c < 2688;
                cur[t4i][i] = ok ? zc[c] : 0.f; prv[t4i][i] = (ok && hp) ? zc[c - ZLD] : 0.f; nxt[t4i][i] = (ok && hn) ? zc[c + ZLD] : 0.f; }
        }
#pragma unroll
        for (int t4i = 0; t4i < 4; ++t4i) {
            const int tt = th * 4 + t4i;
#pragma unroll
            for (int i = 0; i < 6; ++i) {
                const int c = tid + 512 * i;
                if (c < 2688) {
                    float v = cur[t4i][i] + (0.5f * (prv[t4i][i] + nxt[t4i][i]) - cur[t4i][i]) * P.mu[c];
                    if (c < 2304) zm[tt * 2304 + c] = v;
                    else { const int j = c - 2304; if (j < 128) v = tanhf(v); else if (j >= 256) v = sigmoid_f(v); xl[j * 8 + tt] = v; }
                }
            }
        }
    }
    WG_SYNC();
    const int half = __builtin_amdgcn_readfirstlane(tid >> 8);
    int cb_ = tid & 255; asm volatile("" : "+v"(cb_));
    const int cb = cb_;
    const f32x4 z4 = (f32x4){0.f, 0.f, 0.f, 0.f};
    if (half == 0) {
        f32x4 accw[3][2][2], acca[3][2][2];
#pragma unroll
        for (int j = 0; j < 3; ++j)
#pragma unroll
            for (int d = 0; d < 2; ++d) { accw[j][d][0] = accw[j][d][1] = acca[j][d][0] = acca[j][d][1] = z4; }
        float wA[24], aA[24];
#pragma unroll 1
        for (int rb = 0; rb < 16; ++rb) {
            const int r0 = rb * 4;
#pragma unroll
            for (int j = 0; j < 3; ++j)
#pragma unroll
                for (int d = 0; d < 2; ++d)
#pragma unroll
                    for (int rr = 0; rr < 4; ++rr) { const size_t o = ((size_t)d * 64 + r0 + rr) * BWD + cb + 256 * j; wA[(j * 2 + d) * 4 + rr] = P.w2[o]; aA[(j * 2 + d) * 4 + rr] = P.a2[o]; }
#pragma unroll
            for (int d = 0; d < 2; ++d)
#pragma unroll
                for (int rr = 0; rr < 4; ++rr) {
                    const LAS float* xwp = xl + (d * 64 + r0 + rr) * 8; const LAS float* xap = xl + (128 + d * 64 + r0 + rr) * 8;
                    const f32x4 xw0 = *(const LAS f32x4*)xwp, xw1 = *(const LAS f32x4*)(xwp + 4), xa0 = *(const LAS f32x4*)xap, xa1 = *(const LAS f32x4*)(xap + 4);
#pragma unroll
                    for (int j = 0; j < 3; ++j) { const float wv_ = wA[(j * 2 + d) * 4 + rr], av_ = aA[(j * 2 + d) * 4 + rr];
                        accw[j][d][0] += xw0 * wv_; accw[j][d][1] += xw1 * wv_; acca[j][d][0] += xa0 * av_; acca[j][d][1] += xa1 * av_; }
                    __builtin_amdgcn_sched_barrier(0);
                }
        }
#pragma unroll
        for (int j = 0; j < 3; ++j) {
            const int c = cb + 256 * j, head = c >> 6;
            const float w0v[2] = {P.w0[c], P.w0[BWD + c]}, a0v[2] = {P.a0[c], P.a0[BWD + c]}; const float kkwv = P.kkw[c], kawv = P.kaw[c], rkv = P.rk[c];
#pragma unroll
            for (int tt = 0; tt < 8; ++tt) {
                const int m = tok0 + tt;
                const float r_ = zm[tt * 2304 + c], k_ = zm[tt * 2304 + 768 + c];
                float kkv = k_ * kkwv;
                const float nrm = sqrtf(wave_sum(kkv * kkv));
                kkv = kkv / fmaxf(nrm, 1e-12f);
                float bon = 0.f;
#pragma unroll
                for (int d = 0; d < 2; ++d) {
                    const float wraw = w0v[d] + accw[j][d][tt >> 2][tt & 3];
                    const float dec = __expf(-0.6065306597126334f * sigmoid_f(wraw));
                    const float a = sigmoid_f(a0v[d] + acca[j][d][tt >> 2][tt & 3]);
                    const float kd = k_ * (1.f + (a - 1.f) * kawv);
                    const size_t o = ((size_t)d * NTOK + m) * BWD + c;
                    W[o] = dec; KD[o] = kd; Bv[o] = kkv * a;
                    bon += r_ * kd * rkv;
                }
                bon = wave_sum(bon);
                if (lane == 0) BON[m * 12 + head] = bon;
                KK[(size_t)m * BWD + c] = kkv;
            }
        }
    } else {
        f32x4 accg[3][2];
#pragma unroll
        for (int j = 0; j < 3; ++j) accg[j][0] = accg[j][1] = z4;
        float gA[24];
#pragma unroll 1
        for (int rb = 0; rb < 16; ++rb) {
            const int r0 = rb * 8;
#pragma unroll
            for (int j = 0; j < 3; ++j)
#pragma unroll
                for (int rr = 0; rr < 8; ++rr) gA[j * 8 + rr] = P.g2[(size_t)(r0 + rr) * BWD + cb + 256 * j];
#pragma unroll
            for (int rr = 0; rr < 8; ++rr) { const LAS float* xgp = xl + (256 + r0 + rr) * 8; const f32x4 xg0 = *(const LAS f32x4*)xgp, xg1 = *(const LAS f32x4*)(xgp + 4);
#pragma unroll
                for (int j = 0; j < 3; ++j) { accg[j][0] += xg0 * gA[j * 8 + rr]; accg[j][1] += xg1 * gA[j * 8 + rr]; } }
        }
#pragma unroll
        for (int j = 0; j < 3; ++j) {
            const int c = cb + 256 * j;
#pragma unroll
            for (int tt = 0; tt < 8; ++tt) {
                const size_t o = (size_t)(tok0 + tt) * BWD + c;
                R[o] = zm[tt * 2304 + c]; V[o] = zm[tt * 2304 + 1536 + c]; GATE[o] = accg[j][tt >> 2][tt & 3];
            }
        }
    }
    WG_SYNC();
}

__device__ __forceinline__ void hgrn_prep_row(const float* z, const float* hlb, int l, unsigned char* ws, int m, int tid) {
    float* QS = (float*)(ws + WS_QS); float* FG = (float*)(ws + WS_FG);
    const float* zr = z + (size_t)m * ZLD + ZC0;
    for (int c = tid; c < 768; c += 512) {
        QS[(size_t)m * 768 + c] = silu_f(zr[c]);
#pragma unroll
        for (int d = 0; d < 2; ++d) {
            float lbv = 0.f;
            if (l == 1) { const float h0 = hlb[d * 768 + c], h1 = hlb[(2 + d) * 768 + c]; lbv = 1.f / (1.f + __expf(h0 - h1)); }
            FG[((size_t)d * NTOK + m) * 768 + c] = lbv + (1.f - lbv) * sigmoid_f(zr[768 + d * 768 + c]);
        }
    }
}

__device__ __forceinline__ void rwkv_scan_chain(unsigned char* ws, const float* state_in, float* state_out, int l, int chain, int lane) {
    const float* R = (const float*)(ws + WS_R); const float* V = (const float*)(ws + WS_V); const float* KK = (const float*)(ws + WS_KK);
    const float* W = (const float*)(ws + WS_W); const float* KD = (const float*)(ws + WS_KD); const float* Bv = (const float*)(ws + WS_BV); float* Y = (float*)(ws + WS_Y);
    const int dir = chain & 1, head = (chain >> 1) % 12, seq = chain / 24;
    int T, base; float s[64];
    if (seq < 16) {
        T = 256; base = seq * 256;
#pragma unroll
        for (int k = 0; k < 64; ++k) s[k] = 0.f;
    } else {
        const int b = seq - 16; T = 1024; base = 4096 + b * 1024;
        const float* sp = state_in + ((((size_t)(b * 2 + l) * 2 + dir) * 12 + head) * 64 + lane) * 64;
#pragma unroll
        for (int k = 0; k < 64; ++k) s[k] = sp[k];
    }
    for (int step = 0; step < T; ++step) {
        const int t = dir ? T - 1 - step : step, m = base + t;
        const float* rp = R + (size_t)m * BWD + head * 64;
        const float* kkp = KK + (size_t)m * BWD + head * 64;
        const float* wp = W + ((size_t)dir * NTOK + m) * BWD + head * 64;
        const float* kdp = KD + ((size_t)dir * NTOK + m) * BWD + head * 64;
        const float* bp = Bv + ((size_t)dir * NTOK + m) * BWD + head * 64;
        const float vv = V[(size_t)m * BWD + head * 64 + lane];
        float sa = 0.f;
#pragma unroll
        for (int k = 0; k < 64; ++k) sa -= s[k] * kkp[k];
#pragma unroll
        for (int k = 0; k < 64; ++k) s[k] = s[k] * wp[k] + sa * bp[k] + vv * kdp[k];
        float y = 0.f;
#pragma unroll
        for (int k = 0; k < 64; ++k) y += s[k] * rp[k];
        Y[((size_t)dir * NTOK + m) * BWD + head * 64 + lane] = y;
    }
    if (seq < 16) {
        float* sp = state_out + ((((size_t)(seq * 2 + l) * 2 + dir) * 12 + head) * 64 + lane) * 64;
#pragma unroll
        for (int k = 0; k < 64; ++k) sp[k] = s[k];
    }
}
__device__ __forceinline__ void hgrn_scan_half(const float* z, unsigned char* ws, const float* state_in, float* state_out, int l, int item, int lane) {
    const float* QS = (const float*)(ws + WS_QS); const float* FG = (const float*)(ws + WS_FG); float* HO = (float*)(ws + WS_HO);
    const int chain = item >> 1, vcol = (item & 1) * 64 + lane;
    const int dir = chain & 1, head = (chain >> 1) % 6, seq = chain / 12;
    int T, base; float s[128];
    if (seq < 16) {
        T = 256; base = seq * 256;
#pragma unroll
        for (int k = 0; k < 128; ++k) s[k] = 0.f;
    } else {
        const int b = seq - 16; T = 1024; base = 4096 + b * 1024;
        const float* sp = state_in + (((size_t)(b * 2 + l) * 2 + dir) * 6 + head) * 128 * 128 + vcol;
#pragma unroll
        for (int k = 0; k < 128; ++k) s[k] = sp[k * 128];
    }
    for (int step = 0; step < T; ++step) {
        const int t = dir ? T - 1 - step : step, m = base + t;
        const float* qp = QS + (size_t)m * 768 + head * 128;
        const float* fp = FG + ((size_t)dir * NTOK + m) * 768 + head * 128;
        const float vv = z[(size_t)m * ZLD + ZC0 + 2304 + head * 128 + vcol];
        float o = 0.f;
#pragma unroll
        for (int k = 0; k < 128; ++k) { const float f = fp[k]; s[k] = f * s[k] + (1.f - f) * vv; o += s[k] * qp[k]; }
        HO[((size_t)dir * NTOK + m) * 768 + head * 128 + vcol] = o;
    }
    if (seq < 16) {
        float* sp = state_out + (((size_t)(seq * 2 + l) * 2 + dir) * 6 + head) * 128 * 128 + vcol;
#pragma unroll
        for (int k = 0; k < 128; ++k) sp[k * 128] = s[k];
    }
}

__device__ __forceinline__ void rwkv_post_item4(unsigned char* ws, const float* lg, const float* lb, bf16* o, int j, int lane) {
    const float* Y = (const float*)(ws + WS_Y); const float* V = (const float*)(ws + WS_V); const float* GATE = (const float*)(ws + WS_GATE); const float* BON = (const float*)(ws + WS_BON);
    const int m = j / 3, h0 = (j - 3 * m) * 4;
    float y[4], v[4], g[4], bo[4], lgv[4], lbv[4];
#pragma unroll
    for (int q = 0; q < 4; ++q) { const int c = (h0 + q) * 64 + lane; const size_t i = (size_t)m * BWD + c;
        y[q] = Y[i] + Y[(size_t)NTOK * BWD + i]; v[q] = V[i]; g[q] = GATE[i]; bo[q] = BON[m * 12 + h0 + q]; lgv[q] = lg[c]; lbv[q] = lb[c]; }
#pragma unroll
    for (int q = 0; q < 4; ++q) {
        const float mean = wave_sum(y[q]) * (1.f / 64.f);
        const float dv = y[q] - mean;
        const float var = wave_sum(dv * dv) * (1.f / 64.f);
        const float out = dv * rsqrtf(var + 64e-5f) * lgv[q] + lbv[q] + bo[q] * v[q];
        st_bf16(o + (size_t)m * DM + 512 + (h0 + q) * 64 + lane, out * g[q]);
    }
}
__device__ __forceinline__ void hgrn_post_item2(const float* z, unsigned char* ws, const float* gn, bf16* o, int j, int lane) {
    const float* HO = (const float*)(ws + WS_HO);
    const int m = j / 3, h0 = (j - 3 * m) * 2;
    float v0[2], v1[2], g0[2], g1[2];
#pragma unroll
    for (int q = 0; q < 2; ++q) { const size_t i = (size_t)m * 768 + (h0 + q) * 128 + lane; const float* gp = z + (size_t)m * ZLD + ZC0 + 3072 + (h0 + q) * 128;
        v0[q] = HO[i] + HO[(size_t)NTOK * 768 + i]; v1[q] = HO[i + 64] + HO[(size_t)NTOK * 768 + i + 64]; g0[q] = gp[lane]; g1[q] = gp[lane + 64]; }
    const float gn0 = gn[lane], gn1 = gn[lane + 64];
#pragma unroll
    for (int q = 0; q < 2; ++q) {
        const float rstd = rsqrtf(wave_sum(v0[q] * v0[q] + v1[q] * v1[q]) * (1.f / 128.f) + 1e-6f);
        st_bf16(o + (size_t)m * DM + 1280 + (h0 + q) * 128 + lane, v0[q] * rstd * gn0 * silu_f(g0[q]));
        st_bf16(o + (size_t)m * DM + 1280 + (h0 + q) * 128 + lane + 64, v1[q] * rstd * gn1 * silu_f(g1[q]));
    }
}

#define RW_QP(i) " quad_perm:[" #i "," #i "," #i "," #i "] row_mask:0xf bank_mask:0xf bound_ctrl:1"
typedef float f32x2 __attribute__((ext_vector_type(2)));
__device__ __forceinline__ void rw_sa_block(float& sa0, float& sa1, float av, float s0, float s1, float s2, float s3) {
    asm("v_fmac_f32_dpp %0, %2, %3" RW_QP(0) "\n\t"
        "v_fmac_f32_dpp %1, %2, %4" RW_QP(1) "\n\t"
        "v_fmac_f32_dpp %0, %2, %5" RW_QP(2) "\n\t"
        "v_fmac_f32_dpp %1, %2, %6" RW_QP(3)
        : "+v"(sa0), "+v"(sa1) : "v"(av), "v"(s0), "v"(s1), "v"(s2), "v"(s3));
}
__device__ __forceinline__ void rw_upd_block(float& s0, float& s1, float& s2, float& s3, float& y0, float& y1, float wv, float bv, float kdv, float rv, float sa, float vv) {
    asm("v_mul_f32_dpp %0, %6, %0" RW_QP(0) "\n\t"
        "v_mul_f32_dpp %1, %6, %1" RW_QP(1) "\n\t"
        "v_mul_f32_dpp %2, %6, %2" RW_QP(2) "\n\t"
        "v_mul_f32_dpp %3, %6, %3" RW_QP(3) "\n\t"
        "v_fmac_f32_dpp %0, %7, %10" RW_QP(0) "\n\t"
        "v_fmac_f32_dpp %1, %7, %10" RW_QP(1) "\n\t"
        "v_fmac_f32_dpp %2, %7, %10" RW_QP(2) "\n\t"
        "v_fmac_f32_dpp %3, %7, %10" RW_QP(3) "\n\t"
        "v_fmac_f32_dpp %0, %8, %11" RW_QP(0) "\n\t"
        "v_fmac_f32_dpp %1, %8, %11" RW_QP(1) "\n\t"
        "v_fmac_f32_dpp %2, %8, %11" RW_QP(2) "\n\t"
        "v_fmac_f32_dpp %3, %8, %11" RW_QP(3) "\n\t"
        "v_fmac_f32_dpp %4, %9, %0" RW_QP(0) "\n\t"
        "v_fmac_f32_dpp %5, %9, %1" RW_QP(1) "\n\t"
        "v_fmac_f32_dpp %4, %9, %2" RW_QP(2) "\n\t"
        "v_fmac_f32_dpp %5, %9, %3" RW_QP(3)
        : "+v"(s0), "+v"(s1), "+v"(s2), "+v"(s3), "+v"(y0), "+v"(y1) : "v"(wv), "v"(bv), "v"(kdv), "v"(rv), "v"(sa), "v"(vv));
}
__device__ __forceinline__ void rw_sa_block_first(float& sa0, float& sa1, float av, float s0, float s1, float s2, float s3) {
    asm("v_mul_f32_dpp %0, %2, %3" RW_QP(0) "\n\t"
        "v_mul_f32_dpp %1, %2, %4" RW_QP(1) "\n\t"
        "v_fmac_f32_dpp %0, %2, %5" RW_QP(2) "\n\t"
        "v_fmac_f32_dpp %1, %2, %6" RW_QP(3)
        : "=&v"(sa0), "=&v"(sa1) : "v"(av), "v"(s0), "v"(s1), "v"(s2), "v"(s3));
}
__device__ __forceinline__ void rw_upd_block_first(float& s0, float& s1, float& s2, float& s3, float& y0, float& y1, float wv, float bv, float kdv, float rv, float sa, float vv) {
    asm("v_mul_f32_dpp %0, %6, %0" RW_QP(0) "\n\t"
        "v_mul_f32_dpp %1, %6, %1" RW_QP(1) "\n\t"
        "v_mul_f32_dpp %2, %6, %2" RW_QP(2) "\n\t"
        "v_mul_f32_dpp %3, %6, %3" RW_QP(3) "\n\t"
        "v_fmac_f32_dpp %0, %7, %10" RW_QP(0) "\n\t"
        "v_fmac_f32_dpp %1, %7, %10" RW_QP(1) "\n\t"
        "v_fmac_f32_dpp %2, %7, %10" RW_QP(2) "\n\t"
        "v_fmac_f32_dpp %3, %7, %10" RW_QP(3) "\n\t"
        "v_fmac_f32_dpp %0, %8, %11" RW_QP(0) "\n\t"
        "v_fmac_f32_dpp %1, %8, %11" RW_QP(1) "\n\t"
        "v_fmac_f32_dpp %2, %8, %11" RW_QP(2) "\n\t"
        "v_fmac_f32_dpp %3, %8, %11" RW_QP(3) "\n\t"
        "v_mul_f32_dpp %4, %9, %0" RW_QP(0) "\n\t"
        "v_mul_f32_dpp %5, %9, %1" RW_QP(1) "\n\t"
        "v_fmac_f32_dpp %4, %9, %2" RW_QP(2) "\n\t"
        "v_fmac_f32_dpp %5, %9, %3" RW_QP(3)
        : "+v"(s0), "+v"(s1), "+v"(s2), "+v"(s3), "=&v"(y0), "=&v"(y1) : "v"(wv), "v"(bv), "v"(kdv), "v"(rv), "v"(sa), "v"(vv));
}
__device__ __forceinline__ float rw_xsum32(float x) { const unsigned u = __builtin_bit_cast(unsigned, x); auto r = __builtin_amdgcn_permlane32_swap(u, u, false, false); return __builtin_bit_cast(float, (unsigned)r[0]) + __builtin_bit_cast(float, (unsigned)r[1]); }
__device__ __forceinline__ float rw_xsum16(float x) { const unsigned u = __builtin_bit_cast(unsigned, x); auto r = __builtin_amdgcn_permlane16_swap(u, u, false, false); return __builtin_bit_cast(float, (unsigned)r[0]) + __builtin_bit_cast(float, (unsigned)r[1]); }
__device__ __forceinline__ float rw_xsum8(float x) { return x + __builtin_bit_cast(float, __builtin_amdgcn_update_dpp(0, __builtin_bit_cast(int, x), 0x128  , 0xf, 0xf, false)); }
__device__ __forceinline__ float rw_xsum4(float x) { return x + __builtin_bit_cast(float, __builtin_amdgcn_update_dpp(0, __builtin_bit_cast(int, x), 0x124  , 0xf, 0xf, false)); }
template <int KS> __device__ __forceinline__ float rw_kseg_sum(float x) {
    if (KS >= 8) x = rw_xsum8(x);
    if (KS >= 16) x = rw_xsum4(x);
    if (KS >= 4) x = rw_xsum16(x);
    if (KS >= 2) x = rw_xsum32(x);
    return x;
}

template <int NM> __device__ __forceinline__ void rw_ldv(float (&d)[NM], const LAS unsigned char* p) {
    if constexpr (NM == 1) { d[0] = *(const LAS float*)p; }
    else if constexpr (NM == 2) { const f32x2 v = *(const LAS f32x2*)p; d[0] = v.x; d[1] = v.y; }
    else {
#pragma unroll
        for (int m = 0; m < NM; m += 4) { const f32x4 v = *(const LAS f32x4*)(p + m * 4); d[m] = v.x; d[m + 1] = v.y; d[m + 2] = v.z; d[m + 3] = v.w; }
    }
}
template <int N> __device__ __forceinline__ void rw_wait_vm() { asm volatile("s_waitcnt vmcnt(%0) lgkmcnt(0)" :: "n"(N) : "memory"); }
template <int D> __device__ __forceinline__ void rw_ring_wait(int ti, int ntiles) {
#ifdef MK_E1
    rw_wait_vm<0>(); return;
#endif
    const int rem = ntiles - 1 - ti;
    if (ti <= D) rw_wait_vm<6 * (D - 1)>();
    else if (rem >= D - 1) rw_wait_vm<4 * D + 6 * (D - 1)>();
    else if (D >= 3 && rem == 1) rw_wait_vm<4 * D + 6>();
    else rw_wait_vm<4 * D>();
}
template <int KS, int NB>
__device__ __forceinline__ void rwkv_scan_wave(unsigned char* ws, const float* state_in, float* state_out, int l, int chain, int rowblk, LAS unsigned char* wlds, int lane) {
    constexpr int RW = 64 / KS, KL = 64 / KS, NM = KL / 4, TS = 4;
    constexpr int TILE_BYTES = 6 * TS * 256;
    const int rowbase = rowblk * RW;
    const int j = lane & 3, q = lane >> 2, rq = q % (RW / 4), kseg = q / (RW / 4), row = rowbase + 4 * rq + j;
    const int dir = chain & 1, head = (chain >> 1) % 12, seq = chain / 24;
    const int T = seq < 16 ? 256 : 1024, base = seq < 16 ? seq * 256 : 4096 + (seq - 16) * 1024;
    float* Y = (float*)(ws + WS_Y);
    float s[KL];
    if (seq < 16) {
#pragma unroll
        for (int k = 0; k < KL; ++k) s[k] = 0.f;
    } else {
        const float* sp = state_in + (((((size_t)(seq - 16) * 2 + l) * 2 + dir) * 12 + head) * 64 + row) * 64 + kseg * KL;
#pragma unroll
        for (int k = 0; k < KL; k += 4) { const f32x4 v = *(const f32x4*)(sp + k); s[k] = v.x; s[k + 1] = v.y; s[k + 2] = v.z; s[k + 3] = v.w; }
    }
    const int ntiles = T / TS;
    const int tstep = dir ? -TS * BWD * 4 : TS * BWD * 4;
    unsigned vnext;
    { const int st = lane >> 4, tok0 = dir ? T - 1 - st : st; vnext = (unsigned)(((base + tok0) * BWD + head * 64) * 4 + (lane & 15) * 16); }
    const size_t abase[6] = {WS_W + (size_t)dir * SZ_T, WS_KD + (size_t)dir * SZ_T, WS_BV + (size_t)dir * SZ_T, WS_KK, WS_R, WS_V};
#define RW_ISSUE(ti, bufoff) do { _Pragma("unroll") for (int _a = 0; _a < 6; ++_a) \
        __builtin_amdgcn_global_load_lds((const unsigned*)((const char*)ws + abase[_a] + (size_t)vnext), (LAS unsigned*)(wlds + (bufoff) + _a * TS * 256), 16, 0, 0); vnext += (unsigned)tstep; } while (0)
    constexpr int D = NB - 1;
#pragma unroll
    for (int d = 0; d < D; ++d) RW_ISSUE(d, d * TILE_BYTES);
    const unsigned opoff = (unsigned)((kseg * KL + j * NM) * 4), voffv = (unsigned)(5 * TS * 256 + row * 4);
    float ybuf[TS];
    float* yq = Y + ((size_t)dir * NTOK + base + (dir ? T - 1 : 0)) * BWD + head * 64 + row;
    const long ys = dir ? -(long)BWD : (long)BWD;
    int cur = 0, nxt = D;
    for (int ti = 0; ti < ntiles; ++ti) {
        rw_ring_wait<D>(ti, ntiles);
        if (ti + D < ntiles) RW_ISSUE(ti + D, nxt * TILE_BYTES);
        if (ti > 0) {
            if (kseg == 0) { yq[0] = ybuf[0]; yq[ys] = ybuf[1]; yq[2 * ys] = ybuf[2]; yq[3 * ys] = ybuf[3]; }
            yq += 4 * ys;
        }
        const LAS unsigned char* tb = wlds + cur * TILE_BYTES;
        cur = cur + 1 == NB ? 0 : cur + 1; nxt = nxt + 1 == NB ? 0 : nxt + 1;
        float wv[2][NM], kdv[2][NM], bv[2][NM], kkv[2][NM], rv[2][NM], vv[2];
#define RW_LOADOPS(bi, st_) do { rw_ldv<NM>(wv[bi], tb + opoff + (0 * TS + (st_)) * 256); rw_ldv<NM>(kdv[bi], tb + opoff + (1 * TS + (st_)) * 256); rw_ldv<NM>(bv[bi], tb + opoff + (2 * TS + (st_)) * 256); \
            rw_ldv<NM>(kkv[bi], tb + opoff + (3 * TS + (st_)) * 256); rw_ldv<NM>(rv[bi], tb + opoff + (4 * TS + (st_)) * 256); vv[bi] = *(const LAS float*)(tb + voffv + (st_) * 256); } while (0)
        RW_LOADOPS(0, 0);
#pragma unroll
        for (int st = 0; st < TS; ++st) {
            constexpr int dummy = 0; (void)dummy;
            const int cb = st & 1, nb = cb ^ 1;
            if (st + 1 < TS) RW_LOADOPS(nb, st + 1);
            __builtin_amdgcn_sched_barrier(0);
            float sa0, sa1;
            rw_sa_block_first(sa0, sa1, kkv[cb][0], s[0], s[NM], s[2 * NM], s[3 * NM]);
#pragma unroll
            for (int m = 1; m < NM; ++m) rw_sa_block(sa0, sa1, kkv[cb][m], s[m], s[NM + m], s[2 * NM + m], s[3 * NM + m]);
            const float sa = rw_kseg_sum<KS>(-sa0 - sa1);
            float y0, y1;
            rw_upd_block_first(s[0], s[NM], s[2 * NM], s[3 * NM], y0, y1, wv[cb][0], bv[cb][0], kdv[cb][0], rv[cb][0], sa, vv[cb]);
#pragma unroll
            for (int m = 1; m < NM; ++m) rw_upd_block(s[m], s[NM + m], s[2 * NM + m], s[3 * NM + m], y0, y1, wv[cb][m], bv[cb][m], kdv[cb][m], rv[cb][m], sa, vv[cb]);
            ybuf[st] = y0 + y1;
        }
#undef RW_LOADOPS
        if (KS >= 8) {
#pragma unroll
            for (int st = 0; st < TS; ++st) ybuf[st] = rw_xsum8(ybuf[st]);
        }
        if (KS >= 16) {
#pragma unroll
            for (int st = 0; st < TS; ++st) ybuf[st] = rw_xsum4(ybuf[st]);
        }
        if (KS >= 4) {
#pragma unroll
            for (int st = 0; st < TS; ++st) ybuf[st] = rw_xsum16(ybuf[st]);
        }
#pragma unroll
        for (int st = 0; st < TS; ++st) ybuf[st] = rw_xsum32(ybuf[st]);
    }
    if (kseg == 0) {
        yq[0] = ybuf[0]; yq[ys] = ybuf[1]; yq[2 * ys] = ybuf[2]; yq[3 * ys] = ybuf[3];
    }
#undef RW_ISSUE
    if (seq < 16) {
        float* sp = state_out + (((((size_t)seq * 2 + l) * 2 + dir) * 12 + head) * 64 + row) * 64 + kseg * KL;
#pragma unroll
        for (int k = 0; k < KL; k += 4) *(f32x4*)(sp + k) = (f32x4){s[k], s[k + 1], s[k + 2], s[k + 3]};
    }
    asm volatile("s_waitcnt vmcnt(0) lgkmcnt(0)" ::: "memory");
}

#define RQ_P0 " quad_perm:[0,0,2,2] row_mask:0xf bank_mask:0xf bound_ctrl:1"
#define RQ_P1 " quad_perm:[1,1,3,3] row_mask:0xf bank_mask:0xf bound_ctrl:1"
__device__ __forceinline__ void rq_sa_all(float& a0, float& a1, float& a2, float& a3, const float (&kk)[4], const float (&s)[8]) {
    asm("v_fmac_f32_dpp %0, %4, %8" RQ_P0 "\n\t" "v_fmac_f32_dpp %1, %5, %9" RQ_P0 "\n\t" "v_fmac_f32_dpp %2, %6, %10" RQ_P0 "\n\t" "v_fmac_f32_dpp %3, %7, %11" RQ_P0 "\n\t"
        "v_fmac_f32_dpp %0, %4, %12" RQ_P1 "\n\t" "v_fmac_f32_dpp %1, %5, %13" RQ_P1 "\n\t" "v_fmac_f32_dpp %2, %6, %14" RQ_P1 "\n\t" "v_fmac_f32_dpp %3, %7, %15" RQ_P1
        : "+v"(a0), "+v"(a1), "+v"(a2), "+v"(a3) : "v"(kk[0]), "v"(kk[1]), "v"(kk[2]), "v"(kk[3]), "v"(s[0]), "v"(s[1]), "v"(s[2]), "v"(s[3]), "v"(s[4]), "v"(s[5]), "v"(s[6]), "v"(s[7]));
}
__device__ __forceinline__ void rq_upd_all(float (&s)[8], float& y0, float& y1, const float (&w)[4], const float (&b)[4], const float (&kd)[4], const float (&r)[4], float sa, float vv) {
    asm("v_mul_f32_dpp %0, %10, %0" RQ_P0 "\n\t" "v_mul_f32_dpp %1, %11, %1" RQ_P0 "\n\t" "v_mul_f32_dpp %2, %12, %2" RQ_P0 "\n\t" "v_mul_f32_dpp %3, %13, %3" RQ_P0 "\n\t"
        "v_mul_f32_dpp %4, %10, %4" RQ_P1 "\n\t" "v_mul_f32_dpp %5, %11, %5" RQ_P1 "\n\t" "v_mul_f32_dpp %6, %12, %6" RQ_P1 "\n\t" "v_mul_f32_dpp %7, %13, %7" RQ_P1 "\n\t"
        "v_fmac_f32_dpp %0, %14, %26" RQ_P0 "\n\t" "v_fmac_f32_dpp %1, %15, %26" RQ_P0 "\n\t" "v_fmac_f32_dpp %2, %16, %26" RQ_P0 "\n\t" "v_fmac_f32_dpp %3, %17, %26" RQ_P0 "\n\t"
        "v_fmac_f32_dpp %4, %14, %26" RQ_P1 "\n\t" "v_fmac_f32_dpp %5, %15, %26" RQ_P1 "\n\t" "v_fmac_f32_dpp %6, %16, %26" RQ_P1 "\n\t" "v_fmac_f32_dpp %7, %17, %26" RQ_P1 "\n\t"
        "v_fmac_f32_dpp %0, %18, %27" RQ_P0 "\n\t" "v_fmac_f32_dpp %1, %19, %27" RQ_P0 "\n\t" "v_fmac_f32_dpp %2, %20, %27" RQ_P0 "\n\t" "v_fmac_f32_dpp %3, %21, %27" RQ_P0 "\n\t"
        "v_fmac_f32_dpp %4, %18, %27" RQ_P1 "\n\t" "v_fmac_f32_dpp %5, %19, %27" RQ_P1 "\n\t" "v_fmac_f32_dpp %6, %20, %27" RQ_P1 "\n\t" "v_fmac_f32_dpp %7, %21, %27" RQ_P1 "\n\t"
        "v_fmac_f32_dpp %8, %22, %0" RQ_P0 "\n\t" "v_fmac_f32_dpp %9, %23, %1" RQ_P0 "\n\t" "v_fmac_f32_dpp %8, %24, %2" RQ_P0 "\n\t" "v_fmac_f32_dpp %9, %25, %3" RQ_P0 "\n\t"
        "v_fmac_f32_dpp %8, %22, %4" RQ_P1 "\n\t" "v_fmac_f32_dpp %9, %23, %5" RQ_P1 "\n\t" "v_fmac_f32_dpp %8, %24, %6" RQ_P1 "\n\t" "v_fmac_f32_dpp %9, %25, %7" RQ_P1
        : "+v"(s[0]), "+v"(s[1]), "+v"(s[2]), "+v"(s[3]), "+v"(s[4]), "+v"(s[5]), "+v"(s[6]), "+v"(s[7]), "+v"(y0), "+v"(y1)
        : "v"(w[0]), "v"(w[1]), "v"(w[2]), "v"(w[3]), "v"(b[0]), "v"(b[1]), "v"(b[2]), "v"(b[3]), "v"(kd[0]), "v"(kd[1]), "v"(kd[2]), "v"(kd[3]), "v"(r[0]), "v"(r[1]), "v"(r[2]), "v"(r[3]), "v"(sa), "v"(vv));
}
#define RQ_SWP " quad_perm:[2,3,0,1] row_mask:0xf bank_mask:0xf"
__device__ __forceinline__ float rq_sum(float x) {
    float r;
    asm("s_nop 1\n\tv_add_f32_dpp %0, %1, %1" RQ_SWP "\n\ts_nop 1\n\tv_add_f32_dpp %0, %0, %0 row_ror:8 row_mask:0xf bank_mask:0xf\n\ts_nop 1\n\tv_add_f32_dpp %0, %0, %0 row_ror:4 row_mask:0xf bank_mask:0xf"
        : "=&v"(r) : "v"(x));
    return r;
}
__device__ __forceinline__ void rq_sum4(float (&y)[4]) {
    asm("s_nop 1\n\t"
        "v_add_f32_dpp %0, %0, %0" RQ_SWP "\n\t" "v_add_f32_dpp %1, %1, %1" RQ_SWP "\n\t" "v_add_f32_dpp %2, %2, %2" RQ_SWP "\n\t" "v_add_f32_dpp %3, %3, %3" RQ_SWP "\n\t"
        "v_add_f32_dpp %0, %0, %0 row_ror:8 row_mask:0xf bank_mask:0xf\n\t" "v_add_f32_dpp %1, %1, %1 row_ror:8 row_mask:0xf bank_mask:0xf\n\t"
        "v_add_f32_dpp %2, %2, %2 row_ror:8 row_mask:0xf bank_mask:0xf\n\t" "v_add_f32_dpp %3, %3, %3 row_ror:8 row_mask:0xf bank_mask:0xf\n\t"
        "v_add_f32_dpp %0, %0, %0 row_ror:4 row_mask:0xf bank_mask:0xf\n\t" "v_add_f32_dpp %1, %1, %1 row_ror:4 row_mask:0xf bank_mask:0xf\n\t"
        "v_add_f32_dpp %2, %2, %2 row_ror:4 row_mask:0xf bank_mask:0xf\n\t" "v_add_f32_dpp %3, %3, %3 row_ror:4 row_mask:0xf bank_mask:0xf"
        : "+v"(y[0]), "+v"(y[1]), "+v"(y[2]), "+v"(y[3]));
}
template <int NB>
__device__ __forceinline__ void rwkv_scan_wave_l8(unsigned char* ws, const float* state_in, float* state_out, int l, int chain, int rowblk, LAS unsigned char* wlds, int lane) {
    constexpr int KL = 8, TS = 4, TILE_BYTES = 6 * TS * 256;
    const int jr = lane & 1, kseg = ((lane >> 2) & 3) * 2 + ((lane >> 1) & 1), row = rowblk * 8 + 2 * (lane >> 4) + jr;
    const int dir = chain & 1, head = (chain >> 1) % 12, seq = chain / 24;
    const int T = seq < 16 ? 256 : 1024, base = seq < 16 ? seq * 256 : 4096 + (seq - 16) * 1024;
    float* Y = (float*)(ws + WS_Y);
    float s[KL];
    if (seq < 16) {
#pragma unroll
        for (int k = 0; k < KL; ++k) s[k] = 0.f;
    } else {
        const float* sp = state_in + (((((size_t)(seq - 16) * 2 + l) * 2 + dir) * 12 + head) * 64 + row) * 64 + kseg * KL;
        const f32x4 v0 = *(const f32x4*)sp, v1 = *(const f32x4*)(sp + 4);
        s[0] = v0.x; s[1] = v0.y; s[2] = v0.z; s[3] = v0.w; s[4] = v1.x; s[5] = v1.y; s[6] = v1.z; s[7] = v1.w;
    }
    const int ntiles = T / TS;
    const int tstep = dir ? -TS * BWD * 4 : TS * BWD * 4;
    long voff;
    { const int st = lane >> 4, tok0 = dir ? T - 1 - st : st; voff = ((long)(base + tok0) * BWD + head * 64) * 4 + (lane & 15) * 16; }
    const size_t abase[6] = {WS_W + (size_t)dir * SZ_T, WS_KD + (size_t)dir * SZ_T, WS_BV + (size_t)dir * SZ_T, WS_KK, WS_R, WS_V};
#ifdef MK_E1
#define RQ_ISSUE(ti, bufoff) do { _Pragma("unroll") for (int _a = 0; _a < 12; ++_a) \
        __builtin_amdgcn_global_load_lds((const unsigned*)((const char*)ws + abase[_a % 6] + voff + (long)(ti) * tstep), (LAS unsigned*)(wlds + (bufoff) + (_a % 6) * TS * 256), 16, 0, 0); } while (0)
#else
#define RQ_ISSUE(ti, bufoff) do { _Pragma("unroll") for (int _a = 0; _a < 6; ++_a) \
        __builtin_amdgcn_global_load_lds((const unsigned*)((const char*)ws + abase[_a] + voff + (long)(ti) * tstep), (LAS unsigned*)(wlds + (bufoff) + _a * TS * 256), 16, 0, 0); } while (0)
#endif
    constexpr int D = NB - 1;
#pragma unroll
    for (int d = 0; d < D; ++d) RQ_ISSUE(d, d * TILE_BYTES);
    const unsigned opoff = (unsigned)((kseg * KL + jr * 4) * 4), voffv = (unsigned)(5 * TS * 256 + row * 4);
    const bool wr = (lane & 0xE) == 0;
    float ybuf[TS];
    int cur = 0, nxt = D;
    for (int ti = 0; ti < ntiles; ++ti) {
        rw_ring_wait<D>(ti, ntiles);
        if (ti + D < ntiles) RQ_ISSUE(ti + D, nxt * TILE_BYTES);
        if (ti > 0 && wr) {
#pragma unroll
            for (int st = 0; st < TS; ++st) { const int sg = (ti - 1) * TS + st, t = dir ? T - 1 - sg : sg; Y[((size_t)dir * NTOK + base + t) * BWD + head * 64 + row] = ybuf[st]; }
        }
        const LAS unsigned char* tb = wlds + cur * TILE_BYTES;
        cur = cur + 1 == NB ? 0 : cur + 1; nxt = nxt + 1 == NB ? 0 : nxt + 1;
        float wv[2][4], kdv[2][4], bv[2][4], kkv[2][4], rv[2][4], vv[2];
#define RQ_LOADOPS(bi, st_) do { rw_ldv<4>(wv[bi], tb + opoff + (0 * TS + (st_)) * 256); rw_ldv<4>(kdv[bi], tb + opoff + (1 * TS + (st_)) * 256); rw_ldv<4>(bv[bi], tb + opoff + (2 * TS + (st_)) * 256); \
            rw_ldv<4>(kkv[bi], tb + opoff + (3 * TS + (st_)) * 256); rw_ldv<4>(rv[bi], tb + opoff + (4 * TS + (st_)) * 256); vv[bi] = *(const LAS float*)(tb + voffv + (st_) * 256); } while (0)
        RQ_LOADOPS(0, 0);
#pragma unroll
        for (int st = 0; st < TS; ++st) {
            const int cb = st & 1, nb = cb ^ 1;
            if (st + 1 < TS) RQ_LOADOPS(nb, st + 1);
            __builtin_amdgcn_sched_barrier(0);
            float a0 = 0.f, a1 = 0.f, a2 = 0.f, a3 = 0.f;
            rq_sa_all(a0, a1, a2, a3, kkv[cb], s);
            const float sa = -rq_sum((a0 + a1) + (a2 + a3));
            float y0 = 0.f, y1 = 0.f;
            rq_upd_all(s, y0, y1, wv[cb], bv[cb], kdv[cb], rv[cb], sa, vv[cb]);
#ifdef MK_E2
            asm volatile("v_nop\n v_nop\n v_nop\n v_nop\n v_nop\n v_nop\n v_nop\n v_nop\n v_nop\n v_nop\n v_nop\n v_nop\n v_nop\n v_nop\n v_nop\n v_nop\n" ::: "memory");
#endif
            ybuf[st] = y0 + y1;
        }
#undef RQ_LOADOPS
        rq_sum4(ybuf);
    }
#undef RQ_ISSUE
    if (wr) {
#pragma unroll
        for (int st = 0; st < TS; ++st) { const int sg = (ntiles - 1) * TS + st, t = dir ? T - 1 - sg : sg; Y[((size_t)dir * NTOK + base + t) * BWD + head * 64 + row] = ybuf[st]; }
    }
    if (seq < 16) {
        float* sp = state_out + (((((size_t)seq * 2 + l) * 2 + dir) * 12 + head) * 64 + row) * 64 + kseg * KL;
        *(f32x4*)sp = (f32x4){s[0], s[1], s[2], s[3]}; *(f32x4*)(sp + 4) = (f32x4){s[4], s[5], s[6], s[7]};
    }
    asm volatile("s_waitcnt vmcnt(0) lgkmcnt(0)" ::: "memory");
}

template <int N> struct RwWaitTail { static __device__ __forceinline__ void run(int rem) { if (rem >= N) rw_wait_vm<N>(); else RwWaitTail<N - 1>::run(rem); } };
template <> struct RwWaitTail<0> { static __device__ __forceinline__ void run(int) { rw_wait_vm<0>(); } };

__device__ __forceinline__ void rc_step(f32x2& s01, f32x2& s23, float& y, f32x2 w01, f32x2 w23, f32x2 kd01, f32x2 kd23, f32x2 b01, f32x2 b23, f32x2 kk01, f32x2 kk23, f32x2 r01, f32x2 r23, f32x2 vvp) {
    asm volatile(
        "v_pk_mul_f32 v[252:253], %9, %0\n"
        "v_pk_fma_f32 v[252:253], %10, %1, v[252:253]\n"
        "v_pk_mul_f32 %0, %3, %0\n"
        "v_sub_f32_e64 v254, -v252, v253\n"
        "v_pk_mul_f32 %1, %4, %1\n"
        "v_pk_fma_f32 %0, %5, %13, %0 op_sel_hi:[1,0,1]\n"
        "v_add_f32_dpp v254, v254, v254 quad_perm:[1,0,3,2] row_mask:0xf bank_mask:0xf\n"
        "v_pk_fma_f32 %1, %6, %13, %1 op_sel_hi:[1,0,1]\n"
        "s_nop 0\n"
        "v_add_f32_dpp v254, v254, v254 quad_perm:[2,3,0,1] row_mask:0xf bank_mask:0xf\n"
        "s_nop 1\n"
        "v_add_f32_dpp v254, v254, v254 row_ror:4 row_mask:0xf bank_mask:0xf\n"
        "s_nop 1\n"
        "v_add_f32_dpp v254, v254, v254 row_ror:8 row_mask:0xf bank_mask:0xf\n"
        "v_pk_fma_f32 %0, %7, v[254:255], %0 op_sel_hi:[1,0,1]\n"
        "v_pk_fma_f32 %1, %8, v[254:255], %1 op_sel_hi:[1,0,1]\n"
        "v_pk_mul_f32 v[252:253], %11, %0\n"
        "v_pk_fma_f32 v[252:253], %12, %1, v[252:253]\n"
        "v_add_f32_e32 %2, v252, v253\n"
        : "+v"(s01), "+v"(s23), "=&v"(y)
        : "v"(w01), "v"(w23), "v"(kd01), "v"(kd23), "v"(b01), "v"(b23), "v"(kk01), "v"(kk23), "v"(r01), "v"(r23), "v"(vvp)
        : "v252", "v253", "v254", "v255");
}
__device__ __forceinline__ void rc_rowsum4(float (&y)[4]) {
    asm volatile(
        "s_nop 1\n"
        "v_add_f32_dpp %0, %0, %0 quad_perm:[1,0,3,2] row_mask:0xf bank_mask:0xf\n v_add_f32_dpp %1, %1, %1 quad_perm:[1,0,3,2] row_mask:0xf bank_mask:0xf\n"
        "v_add_f32_dpp %2, %2, %2 quad_perm:[1,0,3,2] row_mask:0xf bank_mask:0xf\n v_add_f32_dpp %3, %3, %3 quad_perm:[1,0,3,2] row_mask:0xf bank_mask:0xf\n"
        "v_add_f32_dpp %0, %0, %0 quad_perm:[2,3,0,1] row_mask:0xf bank_mask:0xf\n v_add_f32_dpp %1, %1, %1 quad_perm:[2,3,0,1] row_mask:0xf bank_mask:0xf\n"
        "v_add_f32_dpp %2, %2, %2 quad_perm:[2,3,0,1] row_mask:0xf bank_mask:0xf\n v_add_f32_dpp %3, %3, %3 quad_perm:[2,3,0,1] row_mask:0xf bank_mask:0xf\n"
        "v_add_f32_dpp %0, %0, %0 row_ror:4 row_mask:0xf bank_mask:0xf\n v_add_f32_dpp %1, %1, %1 row_ror:4 row_mask:0xf bank_mask:0xf\n"
        "v_add_f32_dpp %2, %2, %2 row_ror:4 row_mask:0xf bank_mask:0xf\n v_add_f32_dpp %3, %3, %3 row_ror:4 row_mask:0xf bank_mask:0xf\n"
        "v_add_f32_dpp %0, %0, %0 row_ror:8 row_mask:0xf bank_mask:0xf\n v_add_f32_dpp %1, %1, %1 row_ror:8 row_mask:0xf bank_mask:0xf\n"
        "v_add_f32_dpp %2, %2, %2 row_ror:8 row_mask:0xf bank_mask:0xf\n v_add_f32_dpp %3, %3, %3 row_ror:8 row_mask:0xf bank_mask:0xf\n"
        : "+v"(y[0]), "+v"(y[1]), "+v"(y[2]), "+v"(y[3]));
}

__device__ __forceinline__ void rwkv_scan_coop(unsigned char* ws, const float* state_in, float* state_out, int l, int chain, int hb, LAS unsigned char* lds, int wave, int lane) {
    constexpr int TS = 4, TILE_BYTES = 6 * TS * 256, NB = 12, D = NB - 1;
    const int dir = chain & 1, head = (chain >> 1) % 12, seq = chain / 24;
    const int T = seq < 16 ? 256 : 1024, base = seq < 16 ? seq * 256 : 4096 + (seq - 16) * 1024, ntiles = T / TS;
    const int kseg = lane & 15, row = (hb * 8 + wave) * 4 + (lane >> 4);
    f32x2 s01 = {0.f, 0.f}, s23 = {0.f, 0.f};
    if (seq >= 16) {
        const float* sp = state_in + (((((size_t)(seq - 16) * 2 + l) * 2 + dir) * 12 + head) * 64 + row) * 64 + kseg * 4;
        const f32x4 v = *(const f32x4*)sp; s01 = (f32x2){v.x, v.y}; s23 = (f32x2){v.z, v.w};
    }
    const bool issuer = wave < 6;
    const size_t ab = wave == 0 ? WS_W + (size_t)dir * SZ_T : wave == 1 ? WS_KD + (size_t)dir * SZ_T : wave == 2 ? WS_BV + (size_t)dir * SZ_T : wave == 3 ? WS_KK : wave == 4 ? WS_R : WS_V;
    const int tstep = dir ? -TS * BWD * 4 : TS * BWD * 4;
    const char* src;
    { const int st = lane >> 4, tok0 = dir ? T - 1 - st : st; src = (const char*)ws + ab + ((long)(base + tok0) * BWD + head * 64) * 4 + (lane & 15) * 16; }
    LAS unsigned char* dstp = lds + (wave < 6 ? wave : 0) * TS * 256;
    asm volatile("s_waitcnt vmcnt(0) lgkmcnt(0)" ::: "memory");
    __builtin_amdgcn_s_barrier();
    if (issuer) {
#pragma unroll
        for (int d = 0; d < D; ++d) __builtin_amdgcn_global_load_lds((const unsigned*)(src + (long)d * tstep), (LAS unsigned*)(dstp + d * TILE_BYTES), 16, 0, 0);
    }
    float* yp = (float*)(ws + WS_Y) + ((size_t)dir * NTOK + base + (dir ? T - 1 - (kseg & 3) : (kseg & 3))) * BWD + head * 64 + row;
    const long ystep = dir ? -(long)TS * BWD : (long)TS * BWD;
    const unsigned opoff = (unsigned)(kseg * 16), voffv = (unsigned)(5 * TS * 256 + row * 4);
    int cur = 0, nxt = D;
    for (int ti = 0; ti < ntiles; ++ti) {
        const int rem = ntiles - 1 - ti;
        if (issuer) { if (rem >= D - 1) rw_wait_vm<D - 1>(); else RwWaitTail<D - 2>::run(rem); }
        else asm volatile("s_waitcnt lgkmcnt(0)" ::: "memory");
        __builtin_amdgcn_s_barrier();
        if (issuer && ti + D < ntiles) __builtin_amdgcn_global_load_lds((const unsigned*)(src + (long)(ti + D) * tstep), (LAS unsigned*)(dstp + nxt * TILE_BYTES), 16, 0, 0);
        const LAS unsigned char* tb = lds + cur * TILE_BYTES;
        cur = cur + 1 == NB ? 0 : cur + 1; nxt = nxt + 1 == NB ? 0 : nxt + 1;
        f32x4 wv[2], kdv[2], bv[2], kkv[2], rv[2]; f32x2 vv[2]; float ybuf[TS];
#define RC_LOADOPS(bi, st_) do { wv[bi] = *(const LAS f32x4*)(tb + opoff + (0 * TS + (st_)) * 256); kdv[bi] = *(const LAS f32x4*)(tb + opoff + (1 * TS + (st_)) * 256); bv[bi] = *(const LAS f32x4*)(tb + opoff + (2 * TS + (st_)) * 256); \
            kkv[bi] = *(const LAS f32x4*)(tb + opoff + (3 * TS + (st_)) * 256); rv[bi] = *(const LAS f32x4*)(tb + opoff + (4 * TS + (st_)) * 256); vv[bi].x = *(const LAS float*)(tb + voffv + (st_) * 256); } while (0)
        RC_LOADOPS(0, 0);
#pragma unroll
        for (int st = 0; st < TS; ++st) {
            const int cb = st & 1, nb = cb ^ 1;
            if (st + 1 < TS) RC_LOADOPS(nb, st + 1);
            __builtin_amdgcn_sched_barrier(0);
            rc_step(s01, s23, ybuf[st], (f32x2){wv[cb].x, wv[cb].y}, (f32x2){wv[cb].z, wv[cb].w}, (f32x2){kdv[cb].x, kdv[cb].y}, (f32x2){kdv[cb].z, kdv[cb].w}, (f32x2){bv[cb].x, bv[cb].y}, (f32x2){bv[cb].z, bv[cb].w},
                    (f32x2){kkv[cb].x, kkv[cb].y}, (f32x2){kkv[cb].z, kkv[cb].w}, (f32x2){rv[cb].x, rv[cb].y}, (f32x2){rv[cb].z, rv[cb].w}, vv[cb]);
        }
#undef RC_LOADOPS
        rc_rowsum4(ybuf);
        const float val = kseg == 0 ? ybuf[0] : kseg == 1 ? ybuf[1] : kseg == 2 ? ybuf[2] : ybuf[3];
        if (kseg < 4) *yp = val;
        yp += ystep;
    }
    if (seq < 16) {
        float* sp = state_out + (((((size_t)seq * 2 + l) * 2 + dir) * 12 + head) * 64 + row) * 64 + kseg * 4;
        *(f32x4*)sp = (f32x4){s01.x, s01.y, s23.x, s23.y};
    }
    asm volatile("s_waitcnt vmcnt(0) lgkmcnt(0)" ::: "memory");
}

__device__ __forceinline__ void rc8_step(f32x2& s01, f32x2& s23, f32x2& s45, f32x2& s67, float& y, const f32x4 (&w)[2], const f32x4 (&kd)[2], const f32x4 (&b)[2], const f32x4 (&kk)[2], const f32x4 (&r)[2], f32x2 vvp) {
    asm volatile(
        "v_pk_mul_f32 v[248:249], %17, %0\n"
        "v_pk_mul_f32 v[250:251], %18, %1\n"
        "v_pk_fma_f32 v[248:249], %19, %2, v[248:249]\n"
        "v_pk_fma_f32 v[250:251], %20, %3, v[250:251]\n"
        "v_pk_mul_f32 %0, %5, %0\n"
        "v_pk_add_f32 v[248:249], v[248:249], v[250:251]\n"
        "v_pk_mul_f32 %1, %6, %1\n"
        "v_sub_f32_e64 v254, -v248, v249\n"
        "v_pk_mul_f32 %2, %7, %2\n"
        "v_pk_mul_f32 %3, %8, %3\n"
        "v_add_f32_dpp v254, v254, v254 quad_perm:[1,0,3,2] row_mask:0xf bank_mask:0xf\n"
        "v_pk_fma_f32 %0, %9, %25, %0 op_sel_hi:[1,0,1]\n"
        "v_pk_fma_f32 %1, %10, %25, %1 op_sel_hi:[1,0,1]\n"
        "v_add_f32_dpp v254, v254, v254 quad_perm:[2,3,0,1] row_mask:0xf bank_mask:0xf\n"
        "v_pk_fma_f32 %2, %11, %25, %2 op_sel_hi:[1,0,1]\n"
        "v_pk_fma_f32 %3, %12, %25, %3 op_sel_hi:[1,0,1]\n"
        "v_add_f32_dpp v254, v254, v254 row_half_mirror row_mask:0xf bank_mask:0xf\n"
        "v_pk_fma_f32 %0, %13, v[254:255], %0 op_sel_hi:[1,0,1]\n"
        "v_pk_fma_f32 %1, %14, v[254:255], %1 op_sel_hi:[1,0,1]\n"
        "v_pk_fma_f32 %2, %15, v[254:255], %2 op_sel_hi:[1,0,1]\n"
        "v_pk_fma_f32 %3, %16, v[254:255], %3 op_sel_hi:[1,0,1]\n"
        "v_pk_mul_f32 v[248:249], %21, %0\n"
        "v_pk_mul_f32 v[250:251], %22, %1\n"
        "v_pk_fma_f32 v[248:249], %23, %2, v[248:249]\n"
        "v_pk_fma_f32 v[250:251], %24, %3, v[250:251]\n"
        "v_pk_add_f32 v[248:249], v[248:249], v[250:251]\n"
        "v_add_f32_e32 %4, v248, v249\n"
        : "+v"(s01), "+v"(s23), "+v"(s45), "+v"(s67), "=&v"(y)
        : "v"((f32x2){w[0].x, w[0].y}), "v"((f32x2){w[0].z, w[0].w}), "v"((f32x2){w[1].x, w[1].y}), "v"((f32x2){w[1].z, w[1].w}),
          "v"((f32x2){kd[0].x, kd[0].y}), "v"((f32x2){kd[0].z, kd[0].w}), "v"((f32x2){kd[1].x, kd[1].y}), "v"((f32x2){kd[1].z, kd[1].w}),
          "v"((f32x2){b[0].x, b[0].y}), "v"((f32x2){b[0].z, b[0].w}), "v"((f32x2){b[1].x, b[1].y}), "v"((f32x2){b[1].z, b[1].w}),
          "v"((f32x2){kk[0].x, kk[0].y}), "v"((f32x2){kk[0].z, kk[0].w}), "v"((f32x2){kk[1].x, kk[1].y}), "v"((f32x2){kk[1].z, kk[1].w}),
          "v"((f32x2){r[0].x, r[0].y}), "v"((f32x2){r[0].z, r[0].w}), "v"((f32x2){r[1].x, r[1].y}), "v"((f32x2){r[1].z, r[1].w}), "v"(vvp)
        : "v248", "v249", "v250", "v251", "v254", "v255");
}
__device__ __forceinline__ void rc8_rowsum4(float (&y)[4]) {
    asm volatile(
        "s_nop 1\n"
        "v_add_f32_dpp %0, %0, %0 quad_perm:[1,0,3,2] row_mask:0xf bank_mask:0xf\n v_add_f32_dpp %1, %1, %1 quad_perm:[1,0,3,2] row_mask:0xf bank_mask:0xf\n"
        "v_add_f32_dpp %2, %2, %2 quad_perm:[1,0,3,2] row_mask:0xf bank_mask:0xf\n v_add_f32_dpp %3, %3, %3 quad_perm:[1,0,3,2] row_mask:0xf bank_mask:0xf\n"
        "v_add_f32_dpp %0, %0, %0 quad_perm:[2,3,0,1] row_mask:0xf bank_mask:0xf\n v_add_f32_dpp %1, %1, %1 quad_perm:[2,3,0,1] row_mask:0xf bank_mask:0xf\n"
        "v_add_f32_dpp %2, %2, %2 quad_perm:[2,3,0,1] row_mask:0xf bank_mask:0xf\n v_add_f32_dpp %3, %3, %3 quad_perm:[2,3,0,1] row_mask:0xf bank_mask:0xf\n"
        "v_add_f32_dpp %0, %0, %0 row_half_mirror row_mask:0xf bank_mask:0xf\n v_add_f32_dpp %1, %1, %1 row_half_mirror row_mask:0xf bank_mask:0xf\n"
        "v_add_f32_dpp %2, %2, %2 row_half_mirror row_mask:0xf bank_mask:0xf\n v_add_f32_dpp %3, %3, %3 row_half_mirror row_mask:0xf bank_mask:0xf\n"
        : "+v"(y[0]), "+v"(y[1]), "+v"(y[2]), "+v"(y[3]));
}

__device__ __forceinline__ void rwkv_scan_coop8(unsigned char* ws, const float* state_in, float* state_out, int l, int chain, int hb, LAS unsigned char* lds, int wave, int lane) {
    constexpr int TS = 4, TILE_BYTES = 6 * TS * 256, NB = 12, D = NB - 1;
    const int dir = chain & 1, head = (chain >> 1) % 12, seq = chain / 24;
    const int T = seq < 16 ? 256 : 1024, base = seq < 16 ? seq * 256 : 4096 + (seq - 16) * 1024, ntiles = T / TS;
    const int tstep = dir ? -TS * BWD * 4 : TS * BWD * 4;
    if (wave >= 4) {
        const int k = wave - 4;
        const bool loader = k < 3;
        const size_t ab0 = k == 0 ? WS_W + (size_t)dir * SZ_T : k == 1 ? WS_BV + (size_t)dir * SZ_T : WS_R;
        const size_t ab1 = k == 0 ? WS_KD + (size_t)dir * SZ_T : k == 1 ? WS_KK : WS_V;
        const int st = lane >> 4, tok0 = dir ? T - 1 - st : st;
        const long lo = ((long)(base + tok0) * BWD + head * 64) * 4 + (lane & 15) * 16;
        const char* src0 = (const char*)ws + ab0 + lo; const char* src1 = (const char*)ws + ab1 + lo;
        const int pa = k == 0 ? 0 : k == 1 ? 2 : 4, pb = k == 0 ? 1 : k == 1 ? 3 : 5;
        LAS unsigned char* d0 = lds + pa * TS * 256; LAS unsigned char* d1 = lds + pb * TS * 256;
        asm volatile("s_waitcnt vmcnt(0) lgkmcnt(0)" ::: "memory");
        __builtin_amdgcn_s_barrier();
        if (loader) {
#pragma unroll
            for (int d = 0; d < D; ++d) {
                __builtin_amdgcn_global_load_lds((const unsigned*)(src0 + (long)d * tstep), (LAS unsigned*)(d0 + d * TILE_BYTES), 16, 0, 0);
                __builtin_amdgcn_global_load_lds((const unsigned*)(src1 + (long)d * tstep), (LAS unsigned*)(d1 + d * TILE_BYTES), 16, 0, 0);
            }
        }
        int nxt = D;
        for (int ti = 0; ti < ntiles; ++ti) {
            if (ntiles - 1 - ti >= D - 1) rw_wait_vm<2 * (D - 1)>(); else rw_wait_vm<0>();
            __builtin_amdgcn_s_barrier();
            if (loader && ti + D < ntiles) {
                __builtin_amdgcn_global_load_lds((const unsigned*)(src0 + (long)(ti + D) * tstep), (LAS unsigned*)(d0 + nxt * TILE_BYTES), 16, 0, 0);
                __builtin_amdgcn_global_load_lds((const unsigned*)(src1 + (long)(ti + D) * tstep), (LAS unsigned*)(d1 + nxt * TILE_BYTES), 16, 0, 0);
            }
            nxt = nxt + 1 == NB ? 0 : nxt + 1;
        }
    } else {
        const int kseg = lane & 7, row = (hb * 4 + wave) * 8 + (lane >> 3);
        f32x2 s01 = {0.f, 0.f}, s23 = {0.f, 0.f}, s45 = {0.f, 0.f}, s67 = {0.f, 0.f};
        if (seq >= 16) {
            const float* sp = state_in + (((((size_t)(seq - 16) * 2 + l) * 2 + dir) * 12 + head) * 64 + row) * 64 + kseg * 8;
            const f32x4 v0 = *(const f32x4*)sp, v1 = *(const f32x4*)(sp + 4);
            s01 = (f32x2){v0.x, v0.y}; s23 = (f32x2){v0.z, v0.w}; s45 = (f32x2){v1.x, v1.y}; s67 = (f32x2){v1.z, v1.w};
        }
        float* yp = (float*)(ws + WS_Y) + ((size_t)dir * NTOK + base + (dir ? T - 1 - (kseg & 3) : (kseg & 3))) * BWD + head * 64 + row;
        const long ystep = dir ? -(long)TS * BWD : (long)TS * BWD;
        const unsigned opoff = (unsigned)(kseg * 32), voffv = (unsigned)(5 * TS * 256 + row * 4);
        asm volatile("s_waitcnt vmcnt(0) lgkmcnt(0)" ::: "memory");
        __builtin_amdgcn_s_barrier();
        int cur = 0;
        for (int ti = 0; ti < ntiles; ++ti) {
            asm volatile("s_waitcnt lgkmcnt(0)" ::: "memory");
            __builtin_amdgcn_s_barrier();
            const LAS unsigned char* tb = lds + cur * TILE_BYTES;
            cur = cur + 1 == NB ? 0 : cur + 1;
            f32x4 wv[2][2], kdv[2][2], bv[2][2], kkv[2][2], rv[2][2]; f32x2 vv[2]; float ybuf[TS];
#define RC_LD2(dst, a_, st_) do { dst[0] = *(const LAS f32x4*)(tb + opoff + ((a_) * TS + (st_)) * 256); dst[1] = *(const LAS f32x4*)(tb + opoff + ((a_) * TS + (st_)) * 256 + 16); } while (0)
#define RC_LOADOPS(bi, st_) do { RC_LD2(kkv[bi], 3, st_); RC_LD2(wv[bi], 0, st_); RC_LD2(kdv[bi], 1, st_); RC_LD2(bv[bi], 2, st_); RC_LD2(rv[bi], 4, st_); vv[bi].x = *(const LAS float*)(tb + voffv + (st_) * 256); } while (0)
            RC_LOADOPS(0, 0);
#pragma unroll
            for (int st = 0; st < TS; ++st) {
                const int cb = st & 1, nb = cb ^ 1;
                if (st + 1 < TS) RC_LOADOPS(nb, st + 1);
                __builtin_amdgcn_sched_barrier(0);
                rc8_step(s01, s23, s45, s67, ybuf[st], wv[cb], kdv[cb], bv[cb], kkv[cb], rv[cb], vv[cb]);
#ifdef MK_T1
                asm volatile("v_nop\n v_nop\n v_nop\n v_nop\n v_nop\n v_nop\n v_nop\n v_nop\n v_nop\n v_nop\n v_nop\n v_nop\n v_nop\n v_nop\n v_nop\n v_nop\n" ::: "memory");
#endif
#ifdef MK_T2
                asm volatile("v_pk_mul_f32 v[250:251], v[248:249], v[248:249]\n v_pk_mul_f32 v[250:251], v[248:249], v[248:249]\n v_pk_mul_f32 v[250:251], v[248:249], v[248:249]\n v_pk_mul_f32 v[250:251], v[248:249], v[248:249]\n"
                             "v_pk_mul_f32 v[250:251], v[248:249], v[248:249]\n v_pk_mul_f32 v[250:251], v[248:249], v[248:249]\n v_pk_mul_f32 v[250:251], v[248:249], v[248:249]\n v_pk_mul_f32 v[250:251], v[248:249], v[248:249]\n"
                             "v_pk_mul_f32 v[250:251], v[248:249], v[248:249]\n v_pk_mul_f32 v[250:251], v[248:249], v[248:249]\n v_pk_mul_f32 v[250:251], v[248:249], v[248:249]\n v_pk_mul_f32 v[250:251], v[248:249], v[248:249]\n"
                             "v_pk_mul_f32 v[250:251], v[248:249], v[248:249]\n v_pk_mul_f32 v[250:251], v[248:249], v[248:249]\n v_pk_mul_f32 v[250:251], v[248:249], v[248:249]\n v_pk_mul_f32 v[250:251], v[248:249], v[248:249]\n" ::: "memory", "v250", "v251", "v248", "v249");
#endif
#ifdef MK_T3
                asm volatile("v_mul_f32 v250, v248, v248\n v_mul_f32 v250, v248, v248\n v_mul_f32 v250, v248, v248\n v_mul_f32 v250, v248, v248\n v_mul_f32 v250, v248, v248\n v_mul_f32 v250, v248, v248\n v_mul_f32 v250, v248, v248\n v_mul_f32 v250, v248, v248\n"
                             "v_mul_f32 v250, v248, v248\n v_mul_f32 v250, v248, v248\n v_mul_f32 v250, v248, v248\n v_mul_f32 v250, v248, v248\n v_mul_f32 v250, v248, v248\n v_mul_f32 v250, v248, v248\n v_mul_f32 v250, v248, v248\n v_mul_f32 v250, v248, v248\n" ::: "memory", "v250", "v248");
#endif
            }
#undef RC_LOADOPS
#undef RC_LD2
            rc8_rowsum4(ybuf);
            const float val = kseg == 0 ? ybuf[0] : kseg == 1 ? ybuf[1] : kseg == 2 ? ybuf[2] : ybuf[3];
            if (kseg < 4) *yp = val;
            yp += ystep;
        }
        if (seq < 16) {
            float* sp = state_out + (((((size_t)seq * 2 + l) * 2 + dir) * 12 + head) * 64 + row) * 64 + kseg * 8;
            *(f32x4*)sp = (f32x4){s01.x, s01.y, s23.x, s23.y}; *(f32x4*)(sp + 4) = (f32x4){s45.x, s45.y, s67.x, s67.y};
        }
    }
    asm volatile("s_waitcnt vmcnt(0) lgkmcnt(0)" ::: "memory");
    __builtin_amdgcn_s_barrier();
}
typedef float f32x16 __attribute__((ext_vector_type(16)));
constexpr int HG_BLK = 32768;
__device__ __forceinline__ int hg_tau(int s, int h, int jj) { return 16 * s + 8 * (jj >> 2) + 4 * h + (jj & 3); }

__device__ __forceinline__ void hgrn_prep_item(const float* z, const float* hlb, int l, unsigned char* ws, LAS unsigned char* lds, int item, int tid) {
    LAS float* QS = (LAS float*)lds;
    LAS float* FG = (LAS float*)(lds + 16384);
    LAS float* VV = (LAS float*)(lds + 49152);
    LAS bf16* QT = (LAS bf16*)(lds + 65536);
    LAS bf16* KT = (LAS bf16*)(lds + 81920);
    const int gc = item / 6, head = item % 6, t0 = gc * 32;
    {
        const int k = tid & 127, c = head * 128 + k, p0 = tid >> 7;
        float lbv[2] = {0.f, 0.f};
        if (l == 1) {
#pragma unroll
            for (int d = 0; d < 2; ++d) { const float h0 = hlb[d * 768 + c], h1 = hlb[(2 + d) * 768 + c]; lbv[d] = 1.f / (1.f + __expf(h0 - h1)); }
        }
        float zq[8], zv[8], zf0[8], zf1[8];
#pragma unroll
        for (int i = 0; i < 8; ++i) { const float* zr = z + (size_t)(t0 + p0 + 4 * i) * ZLD + ZC0 + c; zq[i] = zr[0]; zv[i] = zr[2304]; zf0[i] = zr[768]; zf1[i] = zr[1536]; }
#pragma unroll
        for (int i = 0; i < 8; ++i) { const int idx = tid + 512 * i;
            QS[idx] = silu_f(zq[i]); VV[idx] = zv[i];
            FG[idx] = lbv[0] + (1.f - lbv[0]) * sigmoid_f(zf0[i]); FG[4096 + idx] = lbv[1] + (1.f - lbv[1]) * sigmoid_f(zf1[i]); }
    }
    WG_SYNC();
    if (tid < 256) {
        const int k = tid & 127, d = tid >> 7; float b = 0.f;
        for (int p = 0; p < 32; ++p) {
            const int tok = d ? 31 - p : p; const float fg = FG[d * 4096 + tok * 128 + k];
            b += __logf(fg);
            QT[d * 4096 + p * 128 + k] = (bf16)f2bf(QS[tok * 128 + k] * __expf(b));
            KT[d * 4096 + p * 128 + k] = (bf16)f2bf((1.f - fg) * __expf(fminf(-b, 80.f)));
        }
        ((float*)(ws + WS_EB))[((size_t)item * 2 + d) * 128 + k] = __expf(b);
    }
    WG_SYNC();
    const int f = tid >> 6, ln = tid & 63, r = ln & 31, h = ln >> 5, kt = f >> 1, s = f & 1;
#pragma unroll
    for (int d = 0; d < 2; ++d) {
        unsigned char* blk = ws + WS_HF + ((size_t)item * 2 + d) * HG_BLK;
        {
            const int k0 = 32 * kt + 16 * s + 4 * h;
            const LAS unsigned long long* qa = (const LAS unsigned long long*)(QT + d * 4096 + r * 128 + k0);
            const LAS unsigned long long* ka = (const LAS unsigned long long*)(KT + d * 4096 + r * 128 + k0);
            typedef unsigned long long u64x2 __attribute__((ext_vector_type(2)));
            *(GAS u64x2*)(blk + f * 1024 + ln * 16) = (u64x2){qa[0], qa[2]};
            *(GAS u64x2*)(blk + 8192 + f * 1024 + ln * 16) = (u64x2){ka[0], ka[2]};
        }
        {
            unsigned w[4];
#pragma unroll
            for (int jp = 0; jp < 4; ++jp) { const unsigned lo = KT[d * 4096 + hg_tau(s, h, 2 * jp) * 128 + 32 * kt + r], hi = KT[d * 4096 + hg_tau(s, h, 2 * jp + 1) * 128 + 32 * kt + r]; w[jp] = lo | (hi << 16); }
            *(GAS v4u*)(blk + 16384 + f * 1024 + ln * 16) = (v4u){w[0], w[1], w[2], w[3]};
        }
        {
            unsigned w[4];
#pragma unroll
            for (int jp = 0; jp < 4; ++jp) { const int p0 = hg_tau(s, h, 2 * jp), p1 = hg_tau(s, h, 2 * jp + 1);
                const float a = VV[(d ? 31 - p0 : p0) * 128 + 32 * kt + r], b2 = VV[(d ? 31 - p1 : p1) * 128 + 32 * kt + r]; w[jp] = pk2(a, b2); }
            *(GAS v4u*)(blk + 24576 + f * 1024 + ln * 16) = (v4u){w[0], w[1], w[2], w[3]};
        }
    }
    WG_SYNC();
}

__device__ __forceinline__ unsigned hg_cvt_pk(float lo, float hi) { unsigned r; asm("v_cvt_pk_bf16_f32 %0, %1, %2" : "=v"(r) : "v"(lo), "v"(hi)); return r; }
__device__ __forceinline__ bf16x8 hg_pack8(const f32x16& x, int s8) {
    v4u w; w.x = hg_cvt_pk(x[s8 + 0], x[s8 + 1]); w.y = hg_cvt_pk(x[s8 + 2], x[s8 + 3]); w.z = hg_cvt_pk(x[s8 + 4], x[s8 + 5]); w.w = hg_cvt_pk(x[s8 + 6], x[s8 + 7]);
    return __builtin_bit_cast(bf16x8, w);
}
__device__ __forceinline__ void hgrn_scan_wave(unsigned char* ws, const float* state_in, float* state_out, int l, int chain, int vs, int lane) {
    const int dir = chain & 1, head = (chain >> 1) % 6, seq = chain / 12;
    const int T = seq < 16 ? 256 : 1024, base = seq < 16 ? seq * 256 : 4096 + (seq - 16) * 1024, NC = T / 32, gc0 = base / 32;
    const int c = lane & 31, h = lane >> 5;
    float* HO = (float*)(ws + WS_HO);
    f32x16 S[4];
    if (seq < 16) {
#pragma unroll
        for (int kt = 0; kt < 4; ++kt)
#pragma unroll
            for (int r = 0; r < 16; ++r) S[kt][r] = 0.f;
    } else {
        const float* sp = state_in + ((((size_t)(seq - 16) * 2 + l) * 2 + dir) * 6 + head) * 128 * 128 + 32 * vs + c;
#pragma unroll
        for (int kt = 0; kt < 4; ++kt)
#pragma unroll
            for (int r = 0; r < 16; ++r) S[kt][r] = sp[(size_t)(32 * kt + (r & 3) + 8 * (r >> 2) + 4 * h) * 128];
    }
    for (int n = 0; n < NC; ++n) {
        const int gc = gc0 + (dir ? NC - 1 - n : n);
        const unsigned char* blk = ws + WS_HF + (((size_t)gc * 6 + head) * 2 + dir) * HG_BLK + lane * 16;
        const float* eb = (const float*)(ws + WS_EB) + (((size_t)gc * 6 + head) * 2 + dir) * 128;
        bf16x8 QF[8], KF[8];
#pragma unroll
        for (int f = 0; f < 8; ++f) { QF[f] = *(const GAS bf16x8*)(blk + f * 1024); KF[f] = *(const GAS bf16x8*)(blk + 8192 + f * 1024); }
        const bf16x8 VF0 = *(const GAS bf16x8*)(blk + 24576 + (vs * 2 + 0) * 1024), VF1 = *(const GAS bf16x8*)(blk + 24576 + (vs * 2 + 1) * 1024);
        bf16x8 KTF[8];
#pragma unroll
        for (int f = 0; f < 8; ++f) KTF[f] = *(const GAS bf16x8*)(blk + 16384 + f * 1024);
        float zz = 0.f; asm volatile("" : "+v"(zz));
        f32x16 att;
#pragma unroll
        for (int r = 0; r < 16; ++r) att[r] = zz;
#pragma unroll
        for (int f = 0; f < 8; ++f) att = __builtin_amdgcn_mfma_f32_32x32x16_bf16(KF[f], QF[f], att, 0, 0, 0);
        f32x16 O;
#pragma unroll
        for (int r = 0; r < 16; ++r) O[r] = zz;
#pragma unroll
        for (int kt = 0; kt < 4; ++kt) {
            O = __builtin_amdgcn_mfma_f32_32x32x16_bf16(QF[2 * kt + 0], hg_pack8(S[kt], 0), O, 0, 0, 0);
            O = __builtin_amdgcn_mfma_f32_32x32x16_bf16(QF[2 * kt + 1], hg_pack8(S[kt], 8), O, 0, 0, 0);
        }
#pragma unroll
        for (int r = 0; r < 16; ++r) { const int j = (r & 3) + 8 * (r >> 2) + 4 * h; att[r] = j <= c ? att[r] : 0.f; }
        O = __builtin_amdgcn_mfma_f32_32x32x16_bf16(hg_pack8(att, 0), VF0, O, 0, 0, 0);
        O = __builtin_amdgcn_mfma_f32_32x32x16_bf16(hg_pack8(att, 8), VF1, O, 0, 0, 0);
#pragma unroll
        for (int r = 0; r < 16; ++r) { const int p = n * 32 + (r & 3) + 8 * (r >> 2) + 4 * h, t = dir ? T - 1 - p : p;
            HO[((size_t)dir * NTOK + base + t) * 768 + head * 128 + 32 * vs + c] = O[r]; }
#pragma unroll
        for (int kt = 0; kt < 4; ++kt) {
            S[kt] = __builtin_amdgcn_mfma_f32_32x32x16_bf16(KTF[2 * kt + 0], VF0, S[kt], 0, 0, 0);
            S[kt] = __builtin_amdgcn_mfma_f32_32x32x16_bf16(KTF[2 * kt + 1], VF1, S[kt], 0, 0, 0);
#pragma unroll
            for (int g = 0; g < 4; ++g) { const f32x4 e = *(const f32x4*)(eb + 32 * kt + 8 * g + 4 * h);
                S[kt][4 * g + 0] *= e.x; S[kt][4 * g + 1] *= e.y; S[kt][4 * g + 2] *= e.z; S[kt][4 * g + 3] *= e.w; }
        }
    }
    if (seq < 16) {
        float* sp = state_out + ((((size_t)seq * 2 + l) * 2 + dir) * 6 + head) * 128 * 128 + 32 * vs + c;
#pragma unroll
        for (int kt = 0; kt < 4; ++kt)
#pragma unroll
            for (int r = 0; r < 16; ++r) sp[(size_t)(32 * kt + (r & 3) + 8 * (r >> 2) + 4 * h) * 128] = S[kt][r];
    }
}
#define AMP_SUB_BEGIN() do { if (MK_AMP >= 0) amp_s0_ = __builtin_amdgcn_s_memrealtime(); } while (0)
#define AMP_SUB_END(code) do { if (MK_AMP == (code)) { __syncthreads(); if (threadIdx.x == 0) { const unsigned long long t1_ = __builtin_amdgcn_s_memrealtime(), dt_ = (t1_ - amp_s0_) * MK_AMPK; \
        while (__builtin_amdgcn_s_memrealtime() - t1_ < dt_) __builtin_amdgcn_s_sleep(32); } __syncthreads(); } } while (0)
__global__ void __launch_bounds__(NWAVES * 64, 2) mega(Args args) {
    extern __shared__ __attribute__((aligned(16))) unsigned char lds_raw[];
    LAS unsigned char* lds = (LAS unsigned char*)lds_raw;
    volatile LAS unsigned* MISC = (volatile LAS unsigned*)(lds + MISC_OFF);
    const int tid_k = threadIdx.x;
    const int G = gridDim.x; const int vcu = (G % 8 == 0) ? ((int)blockIdx.x % 8) * (G / 8) + (int)blockIdx.x / 8 : (int)blockIdx.x;
    unsigned char* ws = args.ws;
    gu32* ctl = (gu32*)(ws + WS_CTL);
    for (int u = tid_k; u < (LDS_BYTES - LDSCTL_OFF) / 4; u += NWAVES * 64) ((LAS unsigned*)(lds + LDSCTL_OFF))[u] = 0u;
    __syncthreads();
    XcdBarrier bar; bar.bar = (unsigned*)(ctl + CW_BAR); bar.x = 0; bar.st = nullptr;
    if (!MK_PER_PHASE) bar = xcd_barrier_post((unsigned*)(ctl + CW_BAR), MISC + 8);

    float* x = args.out;
    float* out_srw = args.out + (size_t)NTOK * DM;
    float* out_shg = out_srw + (size_t)16 * 2 * 2 * 12 * 64 * 64;
    const float* MOD = (const float*)(ws + WS_MOD);
    bf16* H = (bf16*)(ws + WS_H); bf16* Gb = (bf16*)(ws + WS_G); float* Z = (float*)(ws + WS_Z); bf16* O = (bf16*)(ws + WS_O);

#if MK_AMP >= 0
    unsigned long long amp_t0 = __builtin_amdgcn_s_memrealtime();
#endif
    for (int ph = args.ph_lo; ph < args.ph_hi; ++ph) {
        const int nrep = (MK_REP_S >= 0 && ((ph == 0 && MK_REP_S == 100) || (ph > 0 && ph < N_PHASES - 1 && (ph - 1) % 12 == MK_REP_S))) ? 2 : 1;
        for (int rep = 0; rep < nrep; ++rep) {
        int tid = threadIdx.x; asm volatile("" : "+v"(tid));
        const int lane = tid & 63, wave = __builtin_amdgcn_readfirstlane(tid >> 6);
        if (ph == 0) {
            phase_prologue(args, lds, tid, lane, wave, vcu, G);
        } else if (ph == N_PHASES - 1) {
            phase_norm(x, args.in[30], nullptr, 0, nullptr, x, lane, wave, vcu, G);
        } else {
            const int l = (ph - 1) / 12, s = (ph - 1) % 12;
            const float* mod = MOD + (size_t)l * 3 * NMODC;
            if (s == 0 || s == 3 || s == 9) {
                const int i = s == 0 ? 0 : (s == 3 ? 1 : 2);
                phase_norm(x, args.in[6] + (size_t)(l * 3 + i) * DM, mod, 3 * i, H, nullptr, lane, wave, vcu, G);
            } else if (s == 1 || s == 10) {
                const int i = s == 1 ? 0 : 1;
                pg8::Gemm g{H, (const bf16*)(ws + WS_W13 + (size_t)(l * 2 + i) * SZ_W13), NTOK, 2 * DFF, DM}; pg8::StaticOrder S; S.init(NTOK, 2 * DFF, G, (int)blockIdx.x);
                pg8::EpiSwiglu E{Gb, DFF};
                pg8::gemm_phase<pg8::EpiSwiglu, pg8::StaticOrder, true, true>(lds, g, S, E);
            } else if (s == 2 || s == 8 || s == 11) {
                pg8::Gemm g; float scale; int gi;
                if (s == 8) { g = pg8::Gemm{O, (const bf16*)(ws + WS_WOUT + (size_t)l * SZ_WOUT), NTOK, DM, DM}; scale = 1.f; gi = 5; }
                else { const int i = s == 2 ? 0 : 1; g = pg8::Gemm{Gb, (const bf16*)(ws + WS_W2 + (size_t)(l * 2 + i) * SZ_W2), NTOK, DM, DFF}; scale = 0.5f; gi = s == 2 ? 2 : 8; }
                pg8::StaticOrder S; S.init(NTOK, DM, G, (int)blockIdx.x);
                pg8::EpiResid E{x, DM, mod + (size_t)gi * DM, NMODC, scale};
                pg8::gemm_phase<pg8::EpiResid, pg8::StaticOrder, true, true>(lds, g, S, E);
            } else if (s == 4) {
                pg8::Gemm g{H, (const bf16*)(ws + WS_WIN + (size_t)l * SZ_WIN), NTOK, ZLD, DM}; pg8::StaticOrder S; S.init(NTOK, ZLD, G, (int)blockIdx.x);
                pg8::EpiStoreF32 E{Z, ZLD};
                pg8::gemm_phase<pg8::EpiStoreF32, pg8::StaticOrder, true, true>(lds, g, S, E);
            } else if (s == 5) {
                unsigned long long amp_s0_ = 0; (void)amp_s0_;
                AMP_SUB_BEGIN();
                for (int rr = 0; rr < (MK_REP_S == 50 ? 2 : 1); ++rr)
                for (int item = vcu; item < (NTOK / 128) * 4; item += G)
                    chunk_mlp_item(Z, args.in[14] + (size_t)l * 512, args.in[15] + (size_t)l * 4 * 128 * 128, args.in[16] + (size_t)l * 512, O, lds, item, tid, lane, wave);
                const RwkvW P{args.in[17] + (size_t)l * 2688, args.in[18] + (size_t)l * 2 * BWD, args.in[19] + (size_t)l * 2 * 64 * BWD, args.in[20] + (size_t)l * 2 * BWD,
                              args.in[21] + (size_t)l * 2 * 64 * BWD, args.in[22] + (size_t)l * 128 * BWD, args.in[23] + (size_t)l * BWD, args.in[24] + (size_t)l * BWD, args.in[25] + (size_t)l * BWD};
                AMP_SUB_END(50); AMP_SUB_BEGIN();
                for (int rr = 0; rr < (MK_REP_S == 51 ? 2 : 1); ++rr)
                for (int item = vcu; item < NTOK / 8; item += G) rwkv_prep_item(Z, P, ws, lds, item, tid, lane);
                AMP_SUB_END(51); AMP_SUB_BEGIN();
                for (int rr = 0; rr < (MK_REP_S == 52 ? 2 : 1); ++rr)
                for (int item = vcu; item < (NTOK / 32) * 6; item += G) hgrn_prep_item(Z, args.in[28], l, ws, lds, item, tid);
                AMP_SUB_END(52);
            } else if (s == 6) {
                LAS unsigned char* wl = lds + wave * 18432;
                const unsigned long long sc_t0 = (MK_AMP >= 60 && MK_AMP <= 62) ? __builtin_amdgcn_s_memrealtime() : 0ull;
                int sc_role = -1;
                if (vcu < 96) { sc_role = 60; rwkv_scan_coop8(ws, args.in[2], out_srw, l, 384 + (vcu >> 1), vcu & 1, lds, wave, lane); }
                if (MK_AMP == 60 && sc_role == 60) { if (lane == 0) { const unsigned long long t1_ = __builtin_amdgcn_s_memrealtime(), dt_ = (t1_ - sc_t0) * MK_AMPK; while (__builtin_amdgcn_s_memrealtime() - t1_ < dt_) __builtin_amdgcn_s_sleep(32); } }
                if (vcu >= 96) sc_role = 61;
                {
                    unsigned* q = (unsigned*)(ctl + 64 + l * 32);
                    for (;;) {
                        unsigned idx = 0;
                        if (lane == 0) idx = __hip_atomic_fetch_add(q, 1u, __ATOMIC_RELAXED, __HIP_MEMORY_SCOPE_AGENT);
                        idx = (unsigned)__builtin_amdgcn_readfirstlane((int)idx);
                        if (idx >= 96u + 1536u + 768u) break;
                        if (idx >= 96u && idx < 1632u) { const int r = (int)idx - 96; rwkv_scan_wave<4, 3>(ws, args.in[2], out_srw, l, r >> 2, r & 3, wl, lane); }
                        else { const int h = idx < 96u ? 768 + (int)idx : (int)idx - 1632; hgrn_scan_wave(ws, args.in[3], out_shg, l, h >> 2, h & 3, lane); }
                    }
                }
                if ((MK_AMP >= 61 && MK_AMP <= 62) && sc_role == MK_AMP) { if (lane == 0) { const unsigned long long t1_ = __builtin_amdgcn_s_memrealtime(), dt_ = (t1_ - sc_t0) * MK_AMPK; while (__builtin_amdgcn_s_memrealtime() - t1_ < dt_) __builtin_amdgcn_s_sleep(32); } }
            } else if (s == 7) {
                const int gw = vcu * NWAVES + wave, NGW = G * NWAVES;
                for (int it = gw; it < NTOK * 3; it += NGW) rwkv_post_item4(ws, args.in[26] + (size_t)l * BWD, args.in[27] + (size_t)l * BWD, O, it, lane);
                for (int it = gw; it < NTOK * 3; it += NGW) hgrn_post_item2(Z, ws, args.in[29] + (size_t)l * 128, O, it, lane);
            }
        }
        }
        if (ph + 1 < args.ph_hi) xcd_barrier(bar);
#if MK_AMP >= 0
        {
            const int s_ = (ph - 1) % 12;
            const bool hit = (MK_AMP == 0) ? (ph == 0) : (ph > 0 && ph < N_PHASES - 1 && ((MK_AMP == 1 && (s_ == 0 || s_ == 3 || s_ == 9)) || (MK_AMP == 2 && (s_ == 1 || s_ == 10)) || (MK_AMP == 3 && (s_ == 2 || s_ == 11)) ||
                              (MK_AMP >= 4 && MK_AMP <= 8 && s_ == MK_AMP)));
            if (blockIdx.x == 0 && hit) {
                if (threadIdx.x == 0) { const unsigned long long t1 = __builtin_amdgcn_s_memrealtime(), dt = (t1 - amp_t0) * MK_AMPK; while (__builtin_amdgcn_s_memrealtime() - t1 < dt) __builtin_amdgcn_s_sleep(32); }
                __syncthreads();
            }
            amp_t0 = __builtin_amdgcn_s_memrealtime();
        }
#endif
    }
}

extern "C" void kernel_launch(void* const* d_in, const int* in_sizes, int n_in, void* d_out, int out_size, void* d_ws, size_t ws_size, hipStream_t stream) {
    static int grid = 0;
    if (grid == 0) {
        if (n_in != 31 || ws_size < WS_END) { fprintf(stderr, "kernel_launch: built for 31 inputs and >= %zu bytes of workspace; got n_in %d, ws %zu; nothing launched\n", (size_t)WS_END, n_in, ws_size); grid = -1; return; }
        int dev = 0, cus = 0, per_cu = 0;
        if (hipGetDevice(&dev) != hipSuccess || hipDeviceGetAttribute(&cus, hipDeviceAttributeMultiprocessorCount, dev) != hipSuccess) { fprintf(stderr, "kernel_launch: device query failed\n"); grid = -1; return; }
        if (hipFuncSetAttribute((const void*)mega, hipFuncAttributeMaxDynamicSharedMemorySize, LDS_BYTES) != hipSuccess) { fprintf(stderr, "kernel_launch: hipFuncSetAttribute failed\n"); grid = -1; return; }
        if (hipOccupancyMaxActiveBlocksPerMultiprocessor(&per_cu, (const void*)mega, NWAVES * 64, LDS_BYTES) != hipSuccess || per_cu < 1)
            fprintf(stderr, "kernel_launch: note: occupancy query reports %d workgroups per CU\n", per_cu);
        (void)hipGetLastError();
        if (cus != 256) { fprintf(stderr, "kernel_launch: the scan phase's work map is built for 256 CUs, this device reports %d; nothing launched\n", cus); grid = -1; return; }
        grid = cus;
    }
    if (grid < 0) return;
    if (hipMemsetAsync((char*)d_ws + WS_CTL, 0, CTL_ZERO_BYTES, stream) != hipSuccess) { fprintf(stderr, "kernel_launch: hipMemsetAsync failed\n"); return; }
    Args a{};
    for (int i = 0; i < 31; ++i) a.in[i] = (const float*)d_in[i];
    a.out = (float*)d_out; a.ws = (unsigned char*)d_ws;
#if MK_PER_PHASE
    for (int ph = 0; ph < N_PHASES; ++ph) { a.ph_lo = ph; a.ph_hi = ph + 1; a.li = 0; hipLaunchKernelGGL(mega, dim3(grid), dim3(NWAVES * 64), LDS_BYTES, stream, a); }
#else
    a.ph_lo = 0; a.ph_hi = N_PHASES; a.li = 0;
    hipLaunchKernelGGL(mega, dim3(grid), dim3(NWAVES * 64), LDS_BYTES, stream, a);
#endif
    const hipError_t le = hipPeekAtLastError();
    if (le != hipSuccess) fprintf(stderr, "kernel_launch: launch failed: %s\n", hipGetErrorName(le));
}
```
